# Optimizing an MI355X kernel written in HIP

```python
import math
import jax, jax.numpy as jnp
from jax import lax
import numpy as np


D_MODEL = 1024
BATCH = 8
SEQ = 8192
DEPTH = 1
DEC_BATCH = 8
DEC_SEQ = 16
PAST_LEN = 2048

CHUNK = 64
GMLP_CHUNK = 128
GMLP_HEADS = 4
GMLP_HEAD_DIM = 128
GMLP_WIDTH = GMLP_HEADS * GMLP_HEAD_DIM
MLA_HEADS = 4
QK_NOPE_DIM = 128
QK_ROPE_DIM = 64
V_HEAD_DIM = 128
Q_LORA_RANK = 384
KV_LORA_RANK = 256
MLA_WIDTH = MLA_HEADS * V_HEAD_DIM
MIX_WIDTH = GMLP_WIDTH + MLA_WIDTH
IN_SPLITS = (GMLP_WIDTH, 2 * GMLP_WIDTH, 2 * GMLP_WIDTH + Q_LORA_RANK,
             2 * GMLP_WIDTH + Q_LORA_RANK + KV_LORA_RANK)
IN_WIDTH = 2 * GMLP_WIDTH + Q_LORA_RANK + KV_LORA_RANK + QK_ROPE_DIM
D_FF = 2816
CONV_W = 3
ROPE_BASE = 10000.0
Q_BLOCK = 128
ATTN_SCALE = 1.0 / math.sqrt(QK_NOPE_DIM + QK_ROPE_DIM)
DEEPNORM_ALPHA = (2.0 * DEPTH) ** 0.25
DEEPNORM_BETA = (8.0 * DEPTH) ** -0.25
LN_EPS = 1e-5
RMS_EPS = 1e-6
NEG_INF = -1e30

kernel_name = 'hymba_gmlp_mla_convffn_deepnorm_stream_step'


def layer_norm(x, g, b):
    xf = x.astype(jnp.float32)
    mu = jnp.mean(xf, axis=-1, keepdims=True)
    var = jnp.mean(jnp.square(xf - mu), axis=-1, keepdims=True)
    y = (xf - mu) * lax.rsqrt(var + LN_EPS)
    return (y * g.astype(jnp.float32) + b.astype(jnp.float32)).astype(x.dtype)


def rms_norm(x, g):
    xf = x.astype(jnp.float32)
    y = xf * lax.rsqrt(jnp.mean(jnp.square(xf), axis=-1, keepdims=True) + RMS_EPS)
    return (y * g.astype(jnp.float32)).astype(x.dtype)


def rope_tables(pos):
    inv_freq = jnp.power(ROPE_BASE, -jnp.arange(0, QK_ROPE_DIM, 2, dtype=jnp.float32) / QK_ROPE_DIM)
    ang = pos.astype(jnp.float32)[:, None] * inv_freq[None, :]
    return jnp.cos(ang), jnp.sin(ang)


def apply_rope(x, cos, sin):
    half = x.shape[-1] // 2
    x1, x2 = x[..., :half], x[..., half:]
    c = cos.astype(x.dtype)
    s = sin.astype(x.dtype)
    return jnp.concatenate([x1 * c - x2 * s, x2 * c + x1 * s], axis=-1)


def gmlp_spatial(v, w_s, b_s):
    bsz, s_len = v.shape[0], v.shape[1]
    n = min(s_len, GMLP_CHUNK)
    blk = jnp.arange(n) // CHUNK
    mask = blk[None, :] <= blk[:, None]
    w = jnp.where(mask[None], w_s[:, :n, :n], 0.0)
    vc = v.reshape(bsz, s_len // n, n, GMLP_HEADS, GMLP_HEAD_DIM)
    s = jnp.einsum('hij,bcjhd->bcihd', w, vc) + b_s[:, :n].T[:, :, None]
    return s.reshape(bsz, s_len, GMLP_HEADS, GMLP_HEAD_DIM)


def mla_attention(q_lat, q_pe, ckv, kpe, q_offset):
    bsz, s_len = q_lat.shape[0], q_lat.shape[1]
    qb = min(s_len, Q_BLOCK)
    nb = s_len // qb
    k_chunk = jnp.arange(ckv.shape[1]) // CHUNK
    q_pos = q_offset + jnp.arange(s_len)

    def attend_block(args):
        ql, qp, qpos = args
        sc = jnp.einsum('bqhc,bkc->bhqk', ql, ckv) + jnp.einsum('bqhr,bkr->bhqk', qp, kpe)
        sc = sc.astype(jnp.float32) * ATTN_SCALE
        visible = k_chunk[None, :] <= (qpos // CHUNK)[:, None]
        sc = jnp.where(visible[None, None], sc, NEG_INF)
        p = jax.nn.softmax(sc, axis=-1).astype(ckv.dtype)
        return jnp.einsum('bhqk,bkc->bqhc', p, ckv)

    xs = (q_lat.reshape(bsz, nb, qb, MLA_HEADS, KV_LORA_RANK).swapaxes(0, 1),
          q_pe.reshape(bsz, nb, qb, MLA_HEADS, QK_ROPE_DIM).swapaxes(0, 1),
          q_pos.reshape(nb, qb))
    o = lax.map(attend_block, xs)
    return o.swapaxes(0, 1).reshape(bsz, s_len, MLA_HEADS, KV_LORA_RANK)


def token_mixer(x, ckv_past, kpe_past, w_in, ln_v_g, ln_v_b, w_s, b_s, g_q, w_uq,
                g_kv, w_uk, w_uv, w_o):
    bsz, s_len = x.shape[0], x.shape[1]
    past = 0 if ckv_past is None else ckv_past.shape[1]
    proj = jnp.einsum('bsd,de->bse', x, w_in)
    u, v, cq, ckv, kpe = jnp.split(proj, list(IN_SPLITS), axis=-1)
    u = jax.nn.gelu(u)
    v = layer_norm(jax.nn.gelu(v), ln_v_g, ln_v_b)
    sgu = gmlp_spatial(v.reshape(bsz, s_len, GMLP_HEADS, GMLP_HEAD_DIM), w_s, b_s)
    gm = u * sgu.reshape(bsz, s_len, GMLP_WIDTH)
    cos, sin = rope_tables(past + jnp.arange(s_len))
    q = jnp.einsum('bsr,rhd->bshd', rms_norm(cq, g_q), w_uq)
    q_nope = q[..., :QK_NOPE_DIM]
    q_pe = apply_rope(q[..., QK_NOPE_DIM:], cos[:, None, :], sin[:, None, :])
    ckv = rms_norm(ckv, g_kv)
    kpe = apply_rope(kpe, cos, sin)
    if ckv_past is None:
        ckv_all, kpe_all = ckv, kpe
    else:
        ckv_all = jnp.concatenate([ckv_past, ckv], axis=1)
        kpe_all = jnp.concatenate([kpe_past, kpe], axis=1)
    q_lat = jnp.einsum('bshd,chd->bshc', q_nope, w_uk)
    o_lat = mla_attention(q_lat, q_pe, ckv_all, kpe_all, past)
    mla = jnp.einsum('bshc,chd->bshd', o_lat, w_uv).reshape(bsz, s_len, MLA_WIDTH)
    out = jnp.einsum('bse,ed->bsd', jnp.concatenate([gm, mla], axis=-1), w_o)
    return out, ckv, kpe, v


def conv_ffn(x, conv_past, w_up, w_conv, b_conv, w_down):
    bsz, s_len = x.shape[0], x.shape[1]
    up = jnp.einsum('bsd,df->bsf', x, w_up)
    if conv_past is None:
        conv_past = jnp.zeros((bsz, CONV_W - 1, up.shape[-1]), up.dtype)
    padded = jnp.concatenate([conv_past, up], axis=1)
    conv = b_conv
    for k in range(CONV_W):
        conv = conv + w_conv[k] * padded[:, k:k + s_len]
    a, g = jnp.split(conv, 2, axis=-1)
    out = jnp.einsum('bsf,fd->bsd', jax.nn.silu(a) * g, w_down)
    return out, padded[:, padded.shape[1] - (CONV_W - 1):]


def trunk_layer(x, ckv_past, kpe_past, conv_past, w_in, ln_v_g, ln_v_b, w_s, b_s, g_q, w_uq,
                g_kv, w_uk, w_uv, w_o, ln1_g, ln1_b, w_up, w_conv, b_conv, w_down, ln2_g, ln2_b):
    mix, ckv, kpe, v = token_mixer(x, ckv_past, kpe_past, w_in, ln_v_g, ln_v_b, w_s, b_s,
                                   g_q, w_uq, g_kv, w_uk, w_uv, w_o)
    h = layer_norm(DEEPNORM_ALPHA * x + mix, ln1_g, ln1_b)
    ff, conv_state = conv_ffn(h, conv_past, w_up, w_conv, b_conv, w_down)
    y = layer_norm(DEEPNORM_ALPHA * h + ff, ln2_g, ln2_b)
    return y, ckv, kpe, v, conv_state


def setup_inputs(seed: int = 0) -> dict:
    key = jax.random.key(seed)
    ks = jax.random.split(key, 26)

    def nrm(k, shape, scale):
        return jax.random.normal(k, shape, jnp.float32) * scale

    L = DEPTH
    return {
        'x_prompt': nrm(ks[0], (BATCH, SEQ, D_MODEL), 1.0),
        'x_sample': nrm(ks[1], (DEC_BATCH, DEC_SEQ, D_MODEL), 1.0),
        'cache_ckv': nrm(ks[2], (L, DEC_BATCH, PAST_LEN, KV_LORA_RANK), 1.0),
        'cache_kpe': nrm(ks[3], (L, DEC_BATCH, PAST_LEN, QK_ROPE_DIM), 1.0),
        'state_ffn_conv': nrm(ks[4], (L, DEC_BATCH, CONV_W - 1, 2 * D_FF), 1.0),
        'w_in': nrm(ks[5], (L, D_MODEL, IN_WIDTH), D_MODEL ** -0.5),
        'ln_v_g': 1.0 + nrm(ks[6], (L, GMLP_WIDTH), 0.02),
        'ln_v_b': nrm(ks[7], (L, GMLP_WIDTH), 0.02),
        'w_s': nrm(ks[8], (L, GMLP_HEADS, GMLP_CHUNK, GMLP_CHUNK), GMLP_CHUNK ** -0.5),
        'b_s': 1.0 + nrm(ks[9], (L, GMLP_HEADS, GMLP_CHUNK), 0.02),
        'g_q': 1.0 + nrm(ks[10], (L, Q_LORA_RANK), 0.02),
        'w_uq': nrm(ks[11], (L, Q_LORA_RANK, MLA_HEADS, QK_NOPE_DIM + QK_ROPE_DIM), Q_LORA_RANK ** -0.5),
        'g_kv': 1.0 + nrm(ks[12], (L, KV_LORA_RANK), 0.02),
        'w_uk': nrm(ks[13], (L, KV_LORA_RANK, MLA_HEADS, QK_NOPE_DIM), KV_LORA_RANK ** -0.5),
        'w_uv': nrm(ks[14], (L, KV_LORA_RANK, MLA_HEADS, V_HEAD_DIM), KV_LORA_RANK ** -0.5),
        'w_o': nrm(ks[15], (L, MIX_WIDTH, D_MODEL), MIX_WIDTH ** -0.5 * DEEPNORM_BETA),
        'ln1_g': 1.0 + nrm(ks[16], (L, D_MODEL), 0.02),
        'ln1_b': nrm(ks[17], (L, D_MODEL), 0.02),
        'w_up': nrm(ks[18], (L, D_MODEL, 2 * D_FF), D_MODEL ** -0.5),
        'w_conv': nrm(ks[19], (L, CONV_W, 2 * D_FF), CONV_W ** -0.5),
        'b_conv': nrm(ks[20], (L, 2 * D_FF), 0.02),
        'w_down': nrm(ks[21], (L, D_FF, D_MODEL), D_FF ** -0.5 * DEEPNORM_BETA),
        'ln2_g': 1.0 + nrm(ks[22], (L, D_MODEL), 0.02),
        'ln2_b': nrm(ks[23], (L, D_MODEL), 0.02),
    }


def reference(x_prompt, x_sample, cache_ckv, cache_kpe, state_ffn_conv, w_in, ln_v_g, ln_v_b,
              w_s, b_s, g_q, w_uq, g_kv, w_uk, w_uv, w_o, ln1_g, ln1_b, w_up, w_conv, b_conv,
              w_down, ln2_g, ln2_b):
    hp, hs = x_prompt, x_sample
    ckv_p, kpe_p, conv_p = [], [], []
    ckv_s, kpe_s, v_s, conv_s = [], [], [], []
    for l in range(DEPTH):
        lw = (w_in[l], ln_v_g[l], ln_v_b[l], w_s[l], b_s[l], g_q[l], w_uq[l], g_kv[l], w_uk[l],
              w_uv[l], w_o[l], ln1_g[l], ln1_b[l], w_up[l], w_conv[l], b_conv[l], w_down[l],
              ln2_g[l], ln2_b[l])
        hp, ckv_new, kpe_new, _, conv_new = trunk_layer(hp, None, None, None, *lw)
        ckv_p.append(ckv_new)
        kpe_p.append(kpe_new)
        conv_p.append(conv_new)
        hs, ckv_new, kpe_new, v_new, conv_new = trunk_layer(hs, cache_ckv[l], cache_kpe[l],
                                                            state_ffn_conv[l], *lw)
        ckv_s.append(ckv_new)
        kpe_s.append(kpe_new)
        v_s.append(v_new)
        conv_s.append(conv_new)
    return (hp, hs, jnp.stack(ckv_p), jnp.stack(kpe_p), jnp.stack(conv_p),
            jnp.stack(ckv_s), jnp.stack(kpe_s), jnp.stack(v_s), jnp.stack(conv_s))
```

```cpp
#include <hip/hip_runtime.h>
#include <hip/hip_cooperative_groups.h>
#include <cstdio>
#include <cstdint>
namespace cg = cooperative_groups;
namespace pg8 {
#define PG8_LAS __attribute__((address_space(3)))
typedef unsigned short bf16_t;
typedef short bf16x8 __attribute__((ext_vector_type(8)));
typedef float f32x4 __attribute__((ext_vector_type(4)));
typedef unsigned u32x4 __attribute__((ext_vector_type(4)));
constexpr int BM = 256, BK = 64, HALF = 128, HTB = HALF * BK * 2  , STAGE_BYTES = 8 * HTB, NXCD = 8, WGM = 8;

__host__ __device__ __forceinline__ int lds_byte(int r, int c) { const int st = (r >> 4) * 2 + (c >> 5), rr = r & 15, cc = c & 31, ob = rr * 64 + cc * 2; return st * 1024 + (ob ^ (((ob >> 9) & 1) << 5)); }
__host__ __device__ __forceinline__ void stage_rc(int b, int& R, int& C) { const int st = b / 1024, sb = b % 1024, swz = sb ^ (((sb >> 9) & 1) << 5); R = (st >> 1) * 16 + swz / 64; C = (st & 1) * 32 + (swz % 64) / 2; }
__host__ __device__ __forceinline__ int perm32(int rho) { const int n = rho >> 4, i = rho & 15; return 8 * (i >> 2) + 4 * n + (i & 3); }

struct Unit { int pm, pn; };
struct Gemm { const bf16_t* A; const bf16_t* Bt; int M, N, K; };

struct StaticOrder {
    int nM, nN, nwg, G, c;
    __host__ __device__ void init(int M, int N, int G_, int c_) { nM = M / BM; nN = N / BM; nwg = nM * nN; G = G_; c = c_; }
    __host__ __device__ bool next(int i, Unit& u) const {
        const long L = (long)i * G + c; if (L >= nwg) return false;
        int wgid = (int)L; { const int q = nwg / NXCD, r = nwg % NXCD, xcd = wgid % NXCD, off = wgid / NXCD; wgid = (xcd < r ? xcd * (q + 1) : r * (q + 1) + (xcd - r) * q) + off; }
        const int nig = WGM * nN, gid = wgid / nig, fm = gid * WGM, gsz = (nM - fm) < WGM ? (nM - fm) : WGM;
        u.pm = fm + ((wgid % nig) % gsz); u.pn = (wgid % nig) / gsz; return true;
    }
    __device__ __forceinline__ void a_ready(const Unit&) const {}
    __device__ __forceinline__ void done(const Unit&) const {}
};

__device__ __forceinline__ unsigned cvt_pk_bf16(float lo, float hi) { unsigned r; asm volatile("v_cvt_pk_bf16_f32 %0, %1, %2" : "=v"(r) : "v"(lo), "v"(hi)); return r; }
typedef float f32x2 __attribute__((ext_vector_type(2)));
template <class Epi, class Sched, bool ALIGN_EPI = false, bool SP2 = false>
__device__ __forceinline__ void gemm_phase(PG8_LAS unsigned char* lds, const Gemm g, const Sched& S, const Epi& E) {
    const int tid = threadIdx.x, wid = __builtin_amdgcn_readfirstlane(tid >> 6), lane = tid & 63, wr = wid >> 2, wc = wid & 3, fr = lane & 15, fq = lane >> 4;
    const int K = g.K, nt = K / BK;
    unsigned voffA[2], voffB[2];
#pragma unroll
    for (int i = 0; i < 2; ++i) { int R, C; stage_rc(tid * 16 + i * 8192, R, C); const int Rb = Epi::PERM ? ((R & ~31) + perm32(R & 31)) : R;
        voffA[i] = (unsigned)(R * K + C) * 2u; voffB[i] = (unsigned)(Rb * K + C) * 2u; }
    const size_t kstep = (size_t)(BK * 2);
    const size_t hstep = (size_t)HALF * K * 2;
    const size_t tstep = 2 * hstep;
    const unsigned ldsw = (unsigned)wid * 1024u;
    const int aoff = lds_byte(wr * 64 + fr, fq * 8), boff = lds_byte(wc * 32 + fr, fq * 8);
#define PG8_SA(b, h) (((b) * 2 + (h)) * HTB)
#define PG8_SB(b, h) ((4 + (b) * 2 + (h)) * HTB)
#define PG8_STAGE(bufoff, gbase, voff) do { _Pragma("unroll") for (int _i = 0; _i < 2; ++_i) \
        __builtin_amdgcn_global_load_lds((const unsigned*)((const char*)(gbase) + (voff)[_i]), (PG8_LAS unsigned*)(lds + (bufoff) + ldsw + _i * 8192), 16, 0, 0); } while (0)
#define PG8_LDA(dst, b, h) do { _Pragma("unroll") for (int m = 0; m < 4; ++m) _Pragma("unroll") for (int k = 0; k < 2; ++k) dst[m][k] = *(const PG8_LAS bf16x8*)(lds + PG8_SA(b, h) + aoff + m * 2048 + k * 1024); } while (0)
#define PG8_LDB(dst, b, h) do { _Pragma("unroll") for (int n = 0; n < 2; ++n) _Pragma("unroll") for (int k = 0; k < 2; ++k) dst[n][k] = *(const PG8_LAS bf16x8*)(lds + PG8_SB(b, h) + boff + n * 2048 + k * 1024); } while (0)
#define PG8_MMA(ai, bj, At, Bt) do { __builtin_amdgcn_s_setprio(1); _Pragma("unroll") for (int m = 0; m < 4; ++m) _Pragma("unroll") for (int n = 0; n < 2; ++n) _Pragma("unroll") for (int k = 0; k < 2; ++k) \
        acc[ai][bj][m][n] = __builtin_amdgcn_mfma_f32_16x16x32_bf16(Bt[n][k], At[m][k], acc[ai][bj][m][n], 0, 0, 0); __builtin_amdgcn_s_setprio(0); } while (0)
#define PG8_WAIT_V(n) asm volatile("s_waitcnt vmcnt(" #n ")" ::: "memory")
#define PG8_WAIT_L(n) asm volatile("s_waitcnt lgkmcnt(" #n ")" ::: "memory")
#define PG8_BAR __builtin_amdgcn_s_barrier()
#define PG8_SCHED __builtin_amdgcn_sched_barrier(0)
    Unit cur, nxt; int ui = 0;
    if (!S.next(0, cur)) return;
    f32x4 acc[2][2][4][2];
#pragma unroll
    for (int a = 0; a < 2; ++a)
#pragma unroll
        for (int b = 0; b < 2; ++b)
#pragma unroll
            for (int m = 0; m < 4; ++m)
#pragma unroll
                for (int n = 0; n < 2; ++n) acc[a][b][m][n] = (f32x4){0.f, 0.f, 0.f, 0.f};
    bf16x8 At[4][2], B0[2][2], B1[2][2];
    const char* cA = (const char*)g.A + (size_t)cur.pm * tstep; const char* cB = (const char*)g.Bt + (size_t)cur.pn * tstep;
    S.a_ready(cur);
    if constexpr (SP2) {
        PG8_STAGE(PG8_SB(0, 0), cB, voffB); PG8_STAGE(PG8_SB(0, 1), cB + hstep, voffB); PG8_STAGE(PG8_SA(0, 0), cA, voffA); PG8_STAGE(PG8_SA(0, 1), cA + hstep, voffA);
        if (wr == 1) PG8_BAR;
        PG8_WAIT_V(2); PG8_BAR;
        PG8_STAGE(PG8_SB(1, 0), cB + kstep, voffB); PG8_STAGE(PG8_SA(1, 0), cA + kstep, voffA); PG8_STAGE(PG8_SB(1, 1), cB + hstep + kstep, voffB);
        PG8_WAIT_V(6); PG8_BAR;
    } else {
        PG8_STAGE(PG8_SB(0, 0), cB, voffB); PG8_STAGE(PG8_SA(0, 0), cA, voffA); PG8_STAGE(PG8_SB(0, 1), cB + hstep, voffB); PG8_STAGE(PG8_SA(0, 1), cA + hstep, voffA);
        if (wr == 1) PG8_BAR;
        PG8_WAIT_V(4); PG8_BAR;
        PG8_STAGE(PG8_SB(1, 0), cB + kstep, voffB); PG8_STAGE(PG8_SA(1, 0), cA + kstep, voffA); PG8_STAGE(PG8_SB(1, 1), cB + hstep + kstep, voffB);
        PG8_WAIT_V(6); PG8_BAR;
    }
    for (;;) {
        const bool has_next = S.next(ui + 1, nxt);
        const char* nA = has_next ? (const char*)g.A + (size_t)nxt.pm * tstep : cA; const char* nB = has_next ? (const char*)g.Bt + (size_t)nxt.pn * tstep : cB;
        for (int t = 0; t < nt; t += 2) {
            const bool last = (t == nt - 2);
            const char* a1 = cA + (size_t)(t + 1) * kstep;
            const char* a2 = last ? nA : cA + (size_t)(t + 2) * kstep; const char* b2 = last ? nB : cB + (size_t)(t + 2) * kstep;
            const char* a3 = a2 + kstep; const char* b3 = b2 + kstep;
            if (last && has_next) S.a_ready(nxt);
            if constexpr (SP2) {
            PG8_LDB(B0, 0, 0); PG8_LDB(B1, 0, 1); PG8_SCHED; PG8_LDA(At, 0, 0); PG8_STAGE(PG8_SA(1, 1), a1 + hstep, voffA);
            PG8_WAIT_V(8); PG8_WAIT_L(0); PG8_BAR; PG8_MMA(0, 0, At, B0); PG8_MMA(0, 1, At, B1); PG8_BAR; PG8_SCHED;
            PG8_LDA(At, 0, 1); PG8_STAGE(PG8_SB(0, 0), b2, voffB); PG8_STAGE(PG8_SB(0, 1), b2 + hstep, voffB); PG8_STAGE(PG8_SA(0, 0), a2, voffA);
            PG8_WAIT_V(8); PG8_WAIT_L(0); PG8_BAR; PG8_MMA(1, 0, At, B0); PG8_MMA(1, 1, At, B1); PG8_BAR; PG8_SCHED;
            PG8_LDB(B0, 1, 0); PG8_LDB(B1, 1, 1); PG8_SCHED; PG8_LDA(At, 1, 0); PG8_STAGE(PG8_SA(0, 1), a2 + hstep, voffA);
            PG8_WAIT_V(8); PG8_WAIT_L(0); PG8_BAR; PG8_MMA(0, 0, At, B0); PG8_MMA(0, 1, At, B1); PG8_BAR; PG8_SCHED;
            PG8_LDA(At, 1, 1); PG8_STAGE(PG8_SB(1, 0), b3, voffB); PG8_STAGE(PG8_SB(1, 1), b3 + hstep, voffB); PG8_STAGE(PG8_SA(1, 0), a3, voffA);
            PG8_WAIT_V(8); PG8_WAIT_L(0); PG8_BAR; PG8_MMA(1, 0, At, B0); PG8_MMA(1, 1, At, B1); PG8_BAR; PG8_SCHED;
            } else {
            PG8_LDB(B0, 0, 0); PG8_SCHED; PG8_LDA(At, 0, 0); PG8_STAGE(PG8_SA(1, 1), a1 + hstep, voffA);
            PG8_WAIT_L(8); PG8_BAR; PG8_WAIT_L(0); PG8_MMA(0, 0, At, B0); PG8_BAR; PG8_SCHED;
            PG8_LDB(B1, 0, 1); PG8_STAGE(PG8_SB(0, 0), b2, voffB);
            PG8_BAR; PG8_WAIT_L(0); PG8_MMA(0, 1, At, B1); PG8_BAR;
            PG8_LDA(At, 0, 1); PG8_STAGE(PG8_SA(0, 0), a2, voffA);
            PG8_BAR; PG8_WAIT_L(0); PG8_MMA(1, 0, At, B0); PG8_BAR; PG8_SCHED;
            PG8_STAGE(PG8_SB(0, 1), b2 + hstep, voffB);
            PG8_WAIT_V(6); PG8_BAR; PG8_MMA(1, 1, At, B1); PG8_BAR;
            PG8_LDB(B0, 1, 0); PG8_SCHED; PG8_LDA(At, 1, 0); PG8_STAGE(PG8_SA(0, 1), a2 + hstep, voffA);
            PG8_WAIT_L(8); PG8_BAR; PG8_WAIT_L(0); PG8_MMA(0, 0, At, B0); PG8_BAR; PG8_SCHED;
            PG8_LDB(B1, 1, 1); PG8_STAGE(PG8_SB(1, 0), b3, voffB);
            PG8_BAR; PG8_WAIT_L(0); PG8_MMA(0, 1, At, B1); PG8_BAR;
            PG8_LDA(At, 1, 1); PG8_STAGE(PG8_SA(1, 0), a3, voffA);
            PG8_BAR; PG8_WAIT_L(0); PG8_MMA(1, 0, At, B0); PG8_BAR; PG8_SCHED;
            PG8_STAGE(PG8_SB(1, 1), b3 + hstep, voffB);
            PG8_WAIT_V(6); PG8_BAR; PG8_MMA(1, 1, At, B1); PG8_BAR;
            }
        }
        if constexpr (ALIGN_EPI) { if (wr == 0) PG8_BAR; }
        if constexpr (!Epi::AFTER_DRAIN) { E(acc, cur, wr, wc, fr, fq); S.done(cur); }
        if (!has_next) break;
#pragma unroll
        for (int a = 0; a < 2; ++a)
#pragma unroll
            for (int b = 0; b < 2; ++b)
#pragma unroll
                for (int m = 0; m < 4; ++m)
#pragma unroll
                    for (int n = 0; n < 2; ++n) acc[a][b][m][n] = (f32x4){0.f, 0.f, 0.f, 0.f};
        cur = nxt; cA = nA; cB = nB; ++ui;
        if constexpr (ALIGN_EPI) { if (wr == 1) PG8_BAR; }
    }
    PG8_WAIT_V(0);
    if constexpr (!ALIGN_EPI) { if (wr == 0) PG8_BAR; }
    PG8_BAR;
    if constexpr (Epi::AFTER_DRAIN) { E.fused(acc, cur, wr, wc, fr, fq, lds, wid, lane); S.done(cur); }
#undef PG8_SA
#undef PG8_SB
#undef PG8_STAGE
#undef PG8_LDA
#undef PG8_LDB
#undef PG8_MMA
#undef PG8_WAIT_V
#undef PG8_WAIT_L
#undef PG8_BAR
#undef PG8_SCHED
}
}

using pg8::bf16_t; using pg8::bf16x8; using pg8::f32x4; using pg8::u32x4; using pg8::cvt_pk_bf16;
typedef short s16x4 __attribute__((ext_vector_type(4)));
typedef float f32x16 __attribute__((ext_vector_type(16)));
constexpr int TP = 65536, TS = 128, TOK = TP + TS, TOKP = 65792;
constexpr int KVS = 2064, KVR = TP + 8 * KVS, KVRP = 82176;
constexpr int NIN = 1792, DFF = 2816, DFF2 = 5632;
constexpr float ALPHA = 1.189207115002721f;
constexpr float QSCALE = 0.07216878364870323f * 1.4426950408889634f;
constexpr long O_YP = 0, O_CKVP = 67239936L, O_KPEP = 84017152L, O_FCP = 88211456L, O_CKVS = 88301568L, O_KPES = 88334336L, O_GVS = 88342528L, O_FCS = 88408064L, O_END = 88498176L;
constexpr int LDS_BYTES = 131072;
constexpr int HROWS0 = 32768, HROWS1 = TOKP - 32768;
constexpr size_t al256(size_t x) { return (x + 255) / 256 * 256; }
constexpr size_t WS_WIN = 0;
constexpr size_t WS_WUQ = WS_WIN + al256((size_t)NIN * 1024 * 2);
constexpr size_t WS_WKV = WS_WUQ + al256((size_t)768 * 384 * 2);
constexpr size_t WS_WO  = WS_WKV + al256((size_t)1024 * 256 * 2);
constexpr size_t WS_WUP = WS_WO + al256((size_t)1024 * 1024 * 2);
constexpr size_t WS_WDN = WS_WUP + al256((size_t)DFF2 * 1024 * 2);
constexpr size_t WS_WSP = WS_WDN + al256((size_t)1024 * DFF * 2);
constexpr size_t WS_WSS = WS_WSP + al256((size_t)4 * 128 * 128 * 2);
constexpr size_t WS_ROPE = WS_WSS + al256((size_t)4 * 128 * 128 * 2);
constexpr size_t WS_PROJ = WS_ROPE + al256((size_t)8192 * 32 * 8);
constexpr size_t WS_H = WS_PROJ;
constexpr size_t WS_XB = WS_PROJ + al256((size_t)TOKP * NIN * 2);
constexpr size_t WS_VN = WS_XB;
constexpr size_t WS_CQN = WS_VN + al256((size_t)TOKP * 512 * 2);
constexpr size_t WS_CKVN = WS_XB + al256((size_t)TOKP * 1024 * 2);
constexpr size_t WS_KPE = WS_CKVN + al256((size_t)KVRP * 256 * 2);
constexpr size_t WS_QB = WS_KPE + al256((size_t)KVRP * 64 * 2);
constexpr size_t WS_KVB = WS_QB + al256((size_t)TOKP * 768 * 2);
constexpr size_t WS_R1 = WS_KVB;
constexpr size_t WS_CAT = WS_KVB + al256((size_t)KVRP * 1024 * 2);
constexpr size_t WS_END = WS_CAT + al256((size_t)TOKP * 1024 * 2);
constexpr size_t WS_UPH = WS_XB;
constexpr size_t WS_ACTH = WS_UPH + al256((size_t)HROWS1 * DFF2 * 2);
static_assert(WS_ACTH + (size_t)HROWS1 * DFF * 2 <= WS_END, "FFN overlay does not fit");
static_assert(WS_CQN + (size_t)TOKP * 384 * 2 <= WS_CKVN, "VN+CQN overlay does not fit");

struct Params { const float* in[24]; float* out; unsigned char* ws; int ph_lo, ph_hi; };

__device__ __forceinline__ float bf2f(unsigned short h) { return __uint_as_float((unsigned)h << 16); }
__device__ __forceinline__ unsigned short f2bf(float f) { return (unsigned short)(cvt_pk_bf16(f, 0.f) & 0xffffu); }
__device__ __forceinline__ float blo(unsigned w) { return __uint_as_float(w << 16); }
__device__ __forceinline__ float bhi(unsigned w) { return __uint_as_float(w & 0xffff0000u); }
__device__ __forceinline__ float wsum(float v) {
#pragma unroll
    for (int o = 32; o > 0; o >>= 1) v += __shfl_xor(v, o);
    return v; }
__device__ __forceinline__ float gelu_tanh(float x) {
    const float u = 0.7978845608028654f * (x + 0.044715f * x * x * x);
    const float t = __builtin_amdgcn_exp2f(-2.885390081777927f * u);
    return x * __builtin_amdgcn_rcpf(1.f + t); }
__device__ __forceinline__ float silu(float x) { return x * __builtin_amdgcn_rcpf(1.f + __builtin_amdgcn_exp2f(-1.4426950408889634f * x)); }
__device__ __forceinline__ int rope_phys(int Ld) { const int nn = Ld >> 5, i = Ld & 31; return (i >> 4) * 32 + ((i & 15) >> 2) * 8 + nn * 4 + (i & 3); }
__device__ __forceinline__ int tok_pos(int row) { return row < TP ? (row & 8191) : (2048 + (row & 15)); }

namespace pg8 {
struct EpiPlain {
    static constexpr bool PERM = true, AFTER_DRAIN = false;
    bf16_t* O; int ldc; int gelu_tiles; float scale;
    __device__ __forceinline__ void operator()(const f32x4 (&acc)[2][2][4][2], const Unit& u, int wr, int wc, int fr, int fq) const {
        const int row0 = u.pm * BM + wr * 64 + fr, col0 = u.pn * BM + wc * 32 + 8 * fq; const bool g = u.pn < gelu_tiles;
#pragma unroll
        for (int ai = 0; ai < 2; ++ai)
#pragma unroll
            for (int m = 0; m < 4; ++m) { bf16_t* rowp = O + (size_t)(row0 + ai * HALF + m * 16) * ldc + col0;
#pragma unroll
                for (int bj = 0; bj < 2; ++bj) { f32x4 v0 = acc[ai][bj][m][0], v1 = acc[ai][bj][m][1];
                    if (g) {
#pragma unroll
                        for (int e = 0; e < 4; ++e) { v0[e] = gelu_tanh(v0[e]); v1[e] = gelu_tanh(v1[e]); } }
                    v0 = v0 * scale; v1 = v1 * scale;
                    u32x4 w; w.x = cvt_pk_bf16(v0[0], v0[1]); w.y = cvt_pk_bf16(v0[2], v0[3]); w.z = cvt_pk_bf16(v1[0], v1[1]); w.w = cvt_pk_bf16(v1[2], v1[3]);
                    *(u32x4*)(rowp + bj * HALF) = w; } }
    }
};
struct EpiQ {
    static constexpr bool PERM = true, AFTER_DRAIN = false;
    bf16_t* O; const float* rope;
    __device__ __forceinline__ void operator()(const f32x4 (&acc)[2][2][4][2], const Unit& u, int wr, int wc, int fr, int fq) const {
        const int row0 = u.pm * BM + wr * 64 + fr, col0 = u.pn * BM + wc * 32 + 8 * fq;
#pragma unroll
        for (int ai = 0; ai < 2; ++ai)
#pragma unroll
            for (int m = 0; m < 4; ++m) { const int row = row0 + ai * HALF + m * 16; bf16_t* rowp = O + (size_t)row * 768 + col0; const int pos = tok_pos(row);
#pragma unroll
                for (int bj = 0; bj < 2; ++bj) { f32x4 v0 = acc[ai][bj][m][0], v1 = acc[ai][bj][m][1];
                    const int within = (u.pn * BM + bj * HALF + wc * 32) % 192;
                    if (within >= 128) { const int i0 = ((within - 128) >> 5) * 16 + fq * 4; const float* rp = rope + ((size_t)pos * 32 + i0) * 2;
                        const f32x4 c01 = *(const f32x4*)rp, c23 = *(const f32x4*)(rp + 4);
                        const float cs[4] = {c01[0], c01[2], c23[0], c23[2]}, sn[4] = {c01[1], c01[3], c23[1], c23[3]};
#pragma unroll
                        for (int e = 0; e < 4; ++e) { const float x1 = v0[e], x2 = v1[e]; v0[e] = x1 * cs[e] - x2 * sn[e]; v1[e] = x2 * cs[e] + x1 * sn[e]; } }
                    v0 = v0 * QSCALE; v1 = v1 * QSCALE;
                    u32x4 w; w.x = cvt_pk_bf16(v0[0], v0[1]); w.y = cvt_pk_bf16(v0[2], v0[3]); w.z = cvt_pk_bf16(v1[0], v1[1]); w.w = cvt_pk_bf16(v1[2], v1[3]);
                    *(u32x4*)(rowp + bj * HALF) = w; }
                __builtin_amdgcn_sched_barrier(0); }
    }
};
struct EpiWo {
    static constexpr bool PERM = true, AFTER_DRAIN = false;
    bf16_t* O; const float* xp; const float* xs;
    __device__ __forceinline__ void operator()(const f32x4 (&acc)[2][2][4][2], const Unit& u, int wr, int wc, int fr, int fq) const {
        const int row0 = u.pm * BM + wr * 64 + fr, col0 = u.pn * BM + wc * 32 + 8 * fq;
#pragma unroll
        for (int ai = 0; ai < 2; ++ai)
#pragma unroll
            for (int m = 0; m < 4; ++m) { const int row = row0 + ai * HALF + m * 16; if (row >= TOK) continue;
                const float* xr = (row < TP ? xp + (size_t)row * 1024 : xs + (size_t)(row - TP) * 1024) + col0; bf16_t* rowp = O + (size_t)row * 1024 + col0;
#pragma unroll
                for (int bj = 0; bj < 2; ++bj) { const f32x4 a = *(const f32x4*)(xr + bj * HALF), b = *(const f32x4*)(xr + bj * HALF + 4);
                    const f32x4 v0 = acc[ai][bj][m][0] + a * ALPHA, v1 = acc[ai][bj][m][1] + b * ALPHA;
                    u32x4 w; w.x = cvt_pk_bf16(v0[0], v0[1]); w.y = cvt_pk_bf16(v0[2], v0[3]); w.z = cvt_pk_bf16(v1[0], v1[1]); w.w = cvt_pk_bf16(v1[2], v1[3]);
                    *(u32x4*)(rowp + bj * HALF) = w; } }
    }
};
struct EpiDown {
    static constexpr bool PERM = true, AFTER_DRAIN = false;
    float* Y; const bf16_t* H; int row_base;
    __device__ __forceinline__ void operator()(const f32x4 (&acc)[2][2][4][2], const Unit& u, int wr, int wc, int fr, int fq) const {
        const int row0 = row_base + u.pm * BM + wr * 64 + fr, col0 = u.pn * BM + wc * 32 + 8 * fq;
#pragma unroll
        for (int ai = 0; ai < 2; ++ai)
#pragma unroll
            for (int m = 0; m < 4; ++m) { const int row = row0 + ai * HALF + m * 16; if (row >= TOK) continue;
                const bf16_t* hr = H + (size_t)row * 1024 + col0; float* yr = Y + (size_t)row * 1024 + col0;
#pragma unroll
                for (int bj = 0; bj < 2; ++bj) { const u32x4 hw = *(const u32x4*)(hr + bj * HALF);
                    f32x4 v0 = acc[ai][bj][m][0], v1 = acc[ai][bj][m][1];
                    v0[0] += ALPHA * blo(hw.x); v0[1] += ALPHA * bhi(hw.x); v0[2] += ALPHA * blo(hw.y); v0[3] += ALPHA * bhi(hw.y);
                    v1[0] += ALPHA * blo(hw.z); v1[1] += ALPHA * bhi(hw.z); v1[2] += ALPHA * blo(hw.w); v1[3] += ALPHA * bhi(hw.w);
                    *(f32x4*)(yr + bj * HALF) = v0; *(f32x4*)(yr + bj * HALF + 4) = v1; } }
    }
};
}

__device__ void transpose_job(const float* __restrict__ src, int K, int N, bf16_t* __restrict__ dst, int mode, int rowoff, float* tile) {
    const int tid = threadIdx.x, ntn = N / 64, ntot = (K / 64) * ntn;
    for (int tix = blockIdx.x; tix < ntot; tix += gridDim.x) {
        const int kt = tix / ntn, nt = tix % ntn;
        __syncthreads();
#pragma unroll
        for (int i = 0; i < 8; ++i) { const int r = (tid >> 6) + 8 * i, c = tid & 63; tile[r * 65 + c] = src[(size_t)(kt * 64 + r) * N + nt * 64 + c]; }
        __syncthreads();
        const int nn = tid >> 3, kk = (tid & 7) * 8, n = nt * 64 + nn; int drow = n;
        if (mode == 1) { const int h = n / 192, d = n % 192; drow = d < 128 ? n : h * 192 + 128 + rope_phys(d - 128); }
        float v[8];
#pragma unroll
        for (int e = 0; e < 8; ++e) v[e] = tile[(kk + e) * 65 + nn];
        u32x4 w; w.x = cvt_pk_bf16(v[0], v[1]); w.y = cvt_pk_bf16(v[2], v[3]); w.z = cvt_pk_bf16(v[4], v[5]); w.w = cvt_pk_bf16(v[6], v[7]);
        *(u32x4*)(dst + (size_t)(drow + rowoff) * K + kt * 64 + kk) = w;
    }
}
__device__ void p0_prologue(const Params& P, unsigned char* lds) {
    const int tid = threadIdx.x; const long gtid = blockIdx.x * 512L + tid, gsz = gridDim.x * 512L;
    unsigned char* ws = P.ws;
    {
        bf16_t* XB = (bf16_t*)(ws + WS_XB); const long n8 = (long)TOKP * 1024 / 8;
        for (long i = gtid; i < n8; i += gsz) { const long e = i * 8, row = e >> 10; u32x4 w = {0u, 0u, 0u, 0u};
            if (row < TOK) { const float* s = row < TP ? P.in[0] + e : P.in[1] + (e - (long)TP * 1024);
                const f32x4 a = *(const f32x4*)s, b = *(const f32x4*)(s + 4);
                w.x = cvt_pk_bf16(a[0], a[1]); w.y = cvt_pk_bf16(a[2], a[3]); w.z = cvt_pk_bf16(b[0], b[1]); w.w = cvt_pk_bf16(b[2], b[3]); }
            *(u32x4*)(XB + e) = w; }
    }
    {
        bf16_t* CK = (bf16_t*)(ws + WS_CKVN); const long n8 = 8L * 2048 * 256 / 8;
        for (long i = gtid; i < n8; i += gsz) { const long e = i * 8; const int r = (int)(e >> 8), c = (int)(e & 255), b = r >> 11, p = r & 2047;
            const float* s = P.in[2] + e; const f32x4 a = *(const f32x4*)s, bb = *(const f32x4*)(s + 4); u32x4 w;
            w.x = cvt_pk_bf16(a[0], a[1]); w.y = cvt_pk_bf16(a[2], a[3]); w.z = cvt_pk_bf16(bb[0], bb[1]); w.w = cvt_pk_bf16(bb[2], bb[3]);
            *(u32x4*)(CK + (size_t)(TP + b * KVS + p) * 256 + c) = w; }
        for (long i = gtid; i < (long)(KVRP - KVR) * 256; i += gsz) CK[(size_t)KVR * 256 + i] = 0;
        bf16_t* KP = (bf16_t*)(ws + WS_KPE);
        for (long i = gtid; i < 8L * 2048 * 64; i += gsz) { const int r = (int)(i >> 6), d = (int)(i & 63), b = r >> 11, p = r & 2047;
            KP[(size_t)(TP + b * KVS + p) * 64 + rope_phys(d)] = f2bf(P.in[3][i]); }
        for (long i = gtid; i < (long)(KVRP - KVR) * 64; i += gsz) KP[(size_t)KVR * 64 + i] = 0;
    }
    {
        float* RT = (float*)(ws + WS_ROPE);
        for (long i = gtid; i < 8192L * 32; i += gsz) { const int pos = (int)(i >> 5), k = (int)(i & 31);
            const float invf = exp2f(-(float)k * (13.287712379549449f / 32.f)); const float ang = (float)pos * invf;
            double rev = (double)ang * 0.15915494309189535; rev -= floor(rev); const float fr = (float)rev;
            RT[i * 2] = __builtin_amdgcn_cosf(fr); RT[i * 2 + 1] = __builtin_amdgcn_sinf(fr); }
    }
    {
        bf16_t* WP = (bf16_t*)(ws + WS_WSP); bf16_t* WS_ = (bf16_t*)(ws + WS_WSS); const float* w_s = P.in[8];
        for (long i = gtid; i < 4L * 128 * 128; i += gsz) { const int h = (int)(i >> 14), r = (int)(i >> 7) & 127, c = (int)i & 127;
            WP[i] = ((c >> 6) <= (r >> 6)) ? f2bf(w_s[i]) : (bf16_t)0;
            WS_[i] = ((r >> 4) == (c >> 4)) ? f2bf(w_s[h * 16384 + (r & 15) * 128 + (c & 15)]) : (bf16_t)0; }
        bf16_t* WI = (bf16_t*)(ws + WS_WIN);
        for (long i = gtid; i < 64L * 1024; i += gsz) WI[(size_t)1728 * 1024 + i] = 0;
    }
    float* tile = (float*)lds;
    transpose_job(P.in[5], 1024, 1728, (bf16_t*)(ws + WS_WIN), 0, 0, tile);
    transpose_job(P.in[11], 384, 768, (bf16_t*)(ws + WS_WUQ), 1, 0, tile);
    transpose_job(P.in[13], 256, 512, (bf16_t*)(ws + WS_WKV), 0, 0, tile);
    transpose_job(P.in[14], 256, 512, (bf16_t*)(ws + WS_WKV), 0, 512, tile);
    transpose_job(P.in[15], 1024, 1024, (bf16_t*)(ws + WS_WO), 0, 0, tile);
    transpose_job(P.in[18], 1024, DFF2, (bf16_t*)(ws + WS_WUP), 0, 0, tile);
    transpose_job(P.in[21], DFF, 1024, (bf16_t*)(ws + WS_WDN), 0, 0, tile);
    __syncthreads();
}

__device__ void p2_token(const Params& P) {
    unsigned char* ws = P.ws; const int lane = threadIdx.x & 63; const int gw = blockIdx.x * 8 + (threadIdx.x >> 6), nw = gridDim.x * 8;
    const bf16_t* PROJ = (const bf16_t*)(ws + WS_PROJ); bf16_t* VN = (bf16_t*)(ws + WS_VN); bf16_t* CQN = (bf16_t*)(ws + WS_CQN);
    bf16_t* CK = (bf16_t*)(ws + WS_CKVN); bf16_t* KP = (bf16_t*)(ws + WS_KPE); const float* RT = (const float*)(ws + WS_ROPE);
    const float* lng = P.in[6]; const float* lnb = P.in[7]; const float* gq = P.in[10]; const float* gkv = P.in[12];
    float g8[8], b8[8];
#pragma unroll
    for (int e = 0; e < 8; ++e) { g8[e] = lng[lane * 8 + e]; b8[e] = lnb[lane * 8 + e]; }
    float gq6[6], gk4[4];
#pragma unroll
    for (int i = 0; i < 3; ++i) { gq6[2 * i] = gq[128 * i + 2 * lane]; gq6[2 * i + 1] = gq[128 * i + 2 * lane + 1]; }
#pragma unroll
    for (int e = 0; e < 4; ++e) gk4[e] = gkv[lane * 4 + e];
    const int kphys = rope_phys(lane);
    for (int t = gw; t < TOK; t += nw) {
        const bf16_t* pr = PROJ + (size_t)t * NIN;
        const int kvrow = t < TP ? t : TP + ((t - TP) >> 4) * KVS + 2048 + (t & 15);
        {
            const u32x4 w = *(const u32x4*)(pr + 512 + lane * 8);
            float x[8] = {blo(w.x), bhi(w.x), blo(w.y), bhi(w.y), blo(w.z), bhi(w.z), blo(w.w), bhi(w.w)};
            float s = 0.f;
#pragma unroll
            for (int e = 0; e < 8; ++e) s += x[e];
            const float mu = wsum(s) * (1.f / 512.f); float q = 0.f;
#pragma unroll
            for (int e = 0; e < 8; ++e) { x[e] -= mu; q += x[e] * x[e]; }
            const float rstd = rsqrtf(wsum(q) * (1.f / 512.f) + 1e-5f);
#pragma unroll
            for (int e = 0; e < 8; ++e) x[e] = x[e] * rstd * g8[e] + b8[e];
            u32x4 o; o.x = cvt_pk_bf16(x[0], x[1]); o.y = cvt_pk_bf16(x[2], x[3]); o.z = cvt_pk_bf16(x[4], x[5]); o.w = cvt_pk_bf16(x[6], x[7]);
            *(u32x4*)(VN + (size_t)t * 512 + lane * 8) = o;
            if (t >= TP) { float* go = P.out + O_GVS + (size_t)(t - TP) * 512 + lane * 8;
                *(f32x4*)go = (f32x4){x[0], x[1], x[2], x[3]}; *(f32x4*)(go + 4) = (f32x4){x[4], x[5], x[6], x[7]}; }
        }
        {
            float x[6]; float q = 0.f;
#pragma unroll
            for (int i = 0; i < 3; ++i) { const unsigned w = *(const unsigned*)(pr + 1024 + 128 * i + 2 * lane); x[2 * i] = blo(w); x[2 * i + 1] = bhi(w); q += x[2 * i] * x[2 * i] + x[2 * i + 1] * x[2 * i + 1]; }
            const float rstd = rsqrtf(wsum(q) * (1.f / 384.f) + 1e-6f);
#pragma unroll
            for (int i = 0; i < 3; ++i) *(unsigned*)(CQN + (size_t)t * 384 + 128 * i + 2 * lane) = cvt_pk_bf16(x[2 * i] * rstd * gq6[2 * i], x[2 * i + 1] * rstd * gq6[2 * i + 1]);
        }
        {
            const unsigned w0 = *(const unsigned*)(pr + 1408 + lane * 4), w1 = *(const unsigned*)(pr + 1408 + lane * 4 + 2);
            float x[4] = {blo(w0), bhi(w0), blo(w1), bhi(w1)};
            const float rstd = rsqrtf(wsum(x[0] * x[0] + x[1] * x[1] + x[2] * x[2] + x[3] * x[3]) * (1.f / 256.f) + 1e-6f);
#pragma unroll
            for (int e = 0; e < 4; ++e) x[e] = x[e] * rstd * gk4[e];
            float* co = P.out + (t < TP ? O_CKVP + (size_t)t * 256 : O_CKVS + (size_t)(t - TP) * 256) + lane * 4;
            *(f32x4*)co = (f32x4){x[0], x[1], x[2], x[3]};
            unsigned* ck = (unsigned*)(CK + (size_t)kvrow * 256 + lane * 4); ck[0] = cvt_pk_bf16(x[0], x[1]); ck[1] = cvt_pk_bf16(x[2], x[3]);
        }
        {
            const float x = bf2f(pr[1664 + lane]); const float other = __shfl_xor(x, 32); const int i = lane & 31, pos = tok_pos(t);
            const float c = RT[((size_t)pos * 32 + i) * 2], s = RT[((size_t)pos * 32 + i) * 2 + 1];
            const float o = lane < 32 ? x * c - other * s : x * c + other * s;
            P.out[(t < TP ? O_KPEP + (size_t)t * 64 : O_KPES + (size_t)(t - TP) * 64) + lane] = o;
            KP[(size_t)kvrow * 64 + kphys] = f2bf(o);
        }
    }
}

__device__ __forceinline__ int crow(int r, int hi) { return (r & 3) + 8 * (r >> 2) + 4 * hi; }
__device__ void spatial_phase(const Params& P, unsigned char* lds) {
    unsigned char* ws = P.ws; const int tid = threadIdx.x, wid = tid >> 6, lane = tid & 63, r32 = lane & 31, hi = lane >> 5;
    const bf16_t* PROJ = (const bf16_t*)(ws + WS_PROJ); const bf16_t* VN = (const bf16_t*)(ws + WS_VN); bf16_t* CAT = (bf16_t*)(ws + WS_CAT);
    bf16_t* VT = (bf16_t*)lds;
    const float* bs = P.in[9];
    for (int unit = blockIdx.x; unit < 513 * 4; unit += gridDim.x) {
        const int c = unit >> 2, h = unit & 3, tok0 = c * 128; const bool sample = (c == 512);
        const bf16_t* Wm = (const bf16_t*)(ws + (sample ? WS_WSS : WS_WSP)) + h * 16384;
        __syncthreads();
        {   const int j = tid >> 2, dq = (tid & 3) * 32; const bf16_t* src = VN + (size_t)(tok0 + j) * 512 + h * 128 + dq;
#pragma unroll
            for (int i = 0; i < 4; ++i) { const u32x4 w = *(const u32x4*)(src + 8 * i); const unsigned ww[4] = {w.x, w.y, w.z, w.w};
#pragma unroll
                for (int e = 0; e < 4; ++e) { VT[(dq + 8 * i + 2 * e) * 136 + j] = (bf16_t)(ww[e] & 0xffffu); VT[(dq + 8 * i + 2 * e + 1) * 136 + j] = (bf16_t)(ww[e] >> 16); } }
        }
        __syncthreads();
        const int ib = wid >> 1, db0 = (wid & 1) * 2;
        f32x16 a0 = {}, a1 = {};
#pragma unroll
        for (int k = 0; k < 8; ++k) {
            const bf16x8 a = *(const bf16x8*)(Wm + (ib * 32 + r32) * 128 + k * 16 + hi * 8);
            const bf16x8 b0 = *(const bf16x8*)(VT + (db0 * 32 + r32) * 136 + k * 16 + hi * 8);
            const bf16x8 b1 = *(const bf16x8*)(VT + ((db0 + 1) * 32 + r32) * 136 + k * 16 + hi * 8);
            a0 = __builtin_amdgcn_mfma_f32_32x32x16_bf16(a, b0, a0, 0, 0, 0);
            a1 = __builtin_amdgcn_mfma_f32_32x32x16_bf16(a, b1, a1, 0, 0, 0);
        }
#pragma unroll
        for (int r = 0; r < 16; ++r) { const int i = ib * 32 + crow(r, hi), tok = tok0 + i; const float bias = bs[h * 128 + (sample ? (i & 15) : i)];
            const int d0 = h * 128 + db0 * 32 + r32;
            const float u0 = bf2f(PROJ[(size_t)tok * NIN + d0]), u1 = bf2f(PROJ[(size_t)tok * NIN + d0 + 32]);
            CAT[(size_t)tok * 1024 + d0] = f2bf(u0 * (a0[r] + bias)); CAT[(size_t)tok * 1024 + d0 + 32] = f2bf(u1 * (a1[r] + bias)); }
    }
    __syncthreads();
}

namespace att {
constexpr int SHM_V = 16384, SHM_K = 16384, SHM_P = 8192;
constexpr int OFF_V = 0, OFF_K = 2 * SHM_V, OFF_P = OFF_K + 2 * SHM_K, OFF_WS = OFF_P + 2 * SHM_P;
#define KSWZ(row, colB) ((row) * 256 + ((colB) ^ (((row) & 7) << 4)))
#define PSWZ(row, colB) ((row) * 128 + ((colB) ^ (((row) & 7) << 4)))
#define SBAR() __builtin_amdgcn_sched_barrier(0)
__device__ __forceinline__ int v_st(int k, int c) { const int kk = (k & ~0xC) | ((k & 4) << 1) | ((k & 8) >> 1); return ((kk >> 3) * 4 + (c >> 5)) * 512 + ((kk & 7) * 32 + (c & 31)) * 2; }
__device__ __forceinline__ int v_rd_base(int lane) { return ((lane & 3) << 3) | (((lane >> 2) & 3) << 6) | (((lane >> 4) & 1) << 5) | (((lane >> 5) & 1) << 8); }
constexpr int v_rd_off(int d0, int ks, int half) { return d0 * 512 + ks * 4096 + half * 2048; }
template <int OFF> __device__ __forceinline__ s16x4 tr_read(int vb) {
    s16x4 r; asm volatile("ds_read_b64_tr_b16 %0, %1 offset:%2" : "=&v"(r) : "v"(vb), "i"(OFF) : "memory"); return r; }
template <int D0> __device__ __forceinline__ void pv_one(f32x16& od, int vb, bf16x8 pa0, bf16x8 pa1, bf16x8 pa2, bf16x8 pa3) {
    const s16x4 l0 = tr_read<v_rd_off(D0, 0, 0)>(vb), h0 = tr_read<v_rd_off(D0, 0, 1)>(vb), l1 = tr_read<v_rd_off(D0, 1, 0)>(vb), h1 = tr_read<v_rd_off(D0, 1, 1)>(vb);
    const s16x4 l2 = tr_read<v_rd_off(D0, 2, 0)>(vb), h2 = tr_read<v_rd_off(D0, 2, 1)>(vb), l3 = tr_read<v_rd_off(D0, 3, 0)>(vb), h3 = tr_read<v_rd_off(D0, 3, 1)>(vb);
    asm volatile("s_waitcnt lgkmcnt(0)" ::: "memory"); SBAR();
#define PK(L, H) (bf16x8){L[0], L[1], L[2], L[3], H[0], H[1], H[2], H[3]}
    od = __builtin_amdgcn_mfma_f32_32x32x16_bf16(pa0, PK(l0, h0), od, 0, 0, 0);
    od = __builtin_amdgcn_mfma_f32_32x32x16_bf16(pa1, PK(l1, h1), od, 0, 0, 0);
    od = __builtin_amdgcn_mfma_f32_32x32x16_bf16(pa2, PK(l2, h2), od, 0, 0, 0);
    od = __builtin_amdgcn_mfma_f32_32x32x16_bf16(pa3, PK(l3, h3), od, 0, 0, 0);
#undef PK
}
__device__ __forceinline__ void attn_unit(const bf16_t* __restrict__ Qrow  , const float* __restrict__ ropeRow  ,
                                          const bf16_t* __restrict__ KVh  ,
                                          const bf16_t* __restrict__ KPh  , bf16_t* __restrict__ Orow0  ,
                                          int orows  , int NT, int nact, int kvalid, unsigned char* lds) {
    const int tid = threadIdx.x, wid = __builtin_amdgcn_readfirstlane(tid >> 6), lane = tid & 63, r32 = lane & 31, hi = lane >> 5;
    unsigned char* V_lds = lds + OFF_V; unsigned char* K_lds = lds + OFF_K; unsigned char* P_lds = lds + OFF_P;
    float* wsf = (float*)(lds + OFF_WS) + wid * 64; float* li_l = wsf; float* al_l = wsf + 32;
    float m_reg = -1e30f, l_reg = 0.f; f32x16 o[4] = {}; bf16x8 qr[12];
#pragma unroll
    for (int d0 = 0; d0 < 12; ++d0) qr[d0] = *(const bf16x8*)(Qrow + hi * 8 + d0 * 16);
#pragma unroll
    for (int d0 = 0; d0 < 4; ++d0) {
        const int i0 = (d0 >> 1) * 16 + ((d0 & 1) * 2 + hi) * 4; const float* rp = ropeRow + i0 * 2;
        const f32x4 c01 = *(const f32x4*)rp, c23 = *(const f32x4*)(rp + 4);
        const float cs[4] = {c01[0], c01[2], c23[0], c23[2]}, sn[4] = {c01[1], c01[3], c23[1], c23[3]};
        const u32x4 w = *reinterpret_cast<const u32x4*>(&qr[8 + d0]);
        const float x1[4] = {blo(w.x), bhi(w.x), blo(w.y), bhi(w.y)}, x2[4] = {blo(w.z), bhi(w.z), blo(w.w), bhi(w.w)};
        float y1[4], y2[4];
#pragma unroll
        for (int e = 0; e < 4; ++e) { y1[e] = x1[e] * cs[e] - x2[e] * sn[e]; y2[e] = x2[e] * cs[e] + x1[e] * sn[e]; }
        u32x4 ow; ow.x = cvt_pk_bf16(y1[0], y1[1]); ow.y = cvt_pk_bf16(y1[2], y1[3]); ow.z = cvt_pk_bf16(y2[0], y2[1]); ow.w = cvt_pk_bf16(y2[2], y2[3]);
        qr[8 + d0] = *reinterpret_cast<bf16x8*>(&ow);
    }
    int kofs[2], vofs[2], pofs;
#pragma unroll
    for (int i = 0; i < 2; ++i) { const int c = wid + 8 * i;
        { const int row = 4 * c + (lane >> 4), colB = ((lane & 15) * 16) ^ ((row & 7) << 4); kofs[i] = row * 1024 + (colB >> 1); }
        { const int st = 2 * c + (lane >> 5), kk = (st >> 2) * 8 + ((lane & 31) >> 2), col = (st & 3) * 32 + (lane & 3) * 8;
          const int k = (kk & ~0xC) | ((kk & 4) << 1) | ((kk & 8) >> 1); vofs[i] = k * 1024 + 512 + col; } }
    { const int row = wid * 8 + (lane >> 3), colB = ((lane & 7) * 16) ^ ((row & 7) << 4); pofs = row * 64 + (colB >> 1); }
    const int vb0 = (int)(uintptr_t)(V_lds) + v_rd_base(lane);
#define GLDS(gp, lp) __builtin_amdgcn_global_load_lds((const unsigned*)(gp), (PG8_LAS unsigned*)(lp), 16, 0, 0)
#define STAGE_T(k0, b) do { const bf16_t* kb_ = KVh + (size_t)(k0) * 1024; \
        GLDS(kb_ + kofs[0], K_lds + (b) * SHM_K + wid * 1024); GLDS(kb_ + kofs[1], K_lds + (b) * SHM_K + (wid + 8) * 1024); \
        GLDS(kb_ + vofs[0], V_lds + (b) * SHM_V + wid * 1024); GLDS(kb_ + vofs[1], V_lds + (b) * SHM_V + (wid + 8) * 1024); \
        GLDS(KPh + (size_t)(k0) * 64 + pofs, P_lds + (b) * SHM_P + wid * 1024); } while (0)
    STAGE_T(0, 0); asm volatile("s_waitcnt vmcnt(0)" ::: "memory"); __syncthreads();
    for (int j = 0; j < NT; ++j) {
        const int buf = j & 1; const bool more = (j + 1 < NT);
        if (more) STAGE_T((j + 1) * 64, buf ^ 1);
        if (j < nact) {
            const unsigned char* Ks = K_lds + buf * SHM_K; const unsigned char* Ps = P_lds + buf * SHM_P;
            f32x16 p0 = {}, p1 = {};
#pragma unroll
            for (int d0 = 0; d0 < 8; ++d0) { const int cb = (d0 * 16 + hi * 8) * 2;
                const bf16x8 b0 = *(const bf16x8*)(Ks + KSWZ(r32, cb)), b1 = *(const bf16x8*)(Ks + KSWZ(32 + r32, cb));
                p0 = __builtin_amdgcn_mfma_f32_32x32x16_bf16(b0, qr[d0], p0, 0, 0, 0); p1 = __builtin_amdgcn_mfma_f32_32x32x16_bf16(b1, qr[d0], p1, 0, 0, 0); }
#pragma unroll
            for (int d0 = 0; d0 < 4; ++d0) { const int cb = (d0 * 16 + hi * 8) * 2;
                const bf16x8 b0 = *(const bf16x8*)(Ps + PSWZ(r32, cb)), b1 = *(const bf16x8*)(Ps + PSWZ(32 + r32, cb));
                p0 = __builtin_amdgcn_mfma_f32_32x32x16_bf16(b0, qr[8 + d0], p0, 0, 0, 0); p1 = __builtin_amdgcn_mfma_f32_32x32x16_bf16(b1, qr[8 + d0], p1, 0, 0, 0); }
            if (j == NT - 1 && kvalid < 64) {
#pragma unroll
                for (int r = 0; r < 16; ++r) { if (crow(r, hi) >= kvalid) p0[r] = -1e30f; if (32 + crow(r, hi) >= kvalid) p1[r] = -1e30f; } }
            float pmax = p0[0];
#pragma unroll
            for (int r = 1; r < 16; ++r) pmax = fmaxf(pmax, p0[r]);
#pragma unroll
            for (int r = 0; r < 16; ++r) pmax = fmaxf(pmax, p1[r]);
            { auto rr = __builtin_amdgcn_permlane32_swap(__float_as_uint(pmax), __float_as_uint(pmax), false, false); pmax = fmaxf(__uint_as_float(rr[0]), __uint_as_float(rr[1])); }
            const float mn = fmaxf(m_reg, pmax); const float alpha = __builtin_amdgcn_exp2f(m_reg - mn); m_reg = mn;
            float ps = 0.f;
#pragma unroll
            for (int r = 0; r < 16; ++r) { p0[r] = __builtin_amdgcn_exp2f(p0[r] - mn); p1[r] = __builtin_amdgcn_exp2f(p1[r] - mn); ps += p0[r] + p1[r]; }
            { auto rr = __builtin_amdgcn_permlane32_swap(__float_as_uint(ps), __float_as_uint(ps), false, false); ps = __uint_as_float(rr[0]) + __uint_as_float(rr[1]); }
            l_reg = l_reg * alpha + ps;
            bf16x8 pa0, pa1, pa2, pa3;
#define PK4(Pv, BASE, OUT) do { unsigned a0 = cvt_pk_bf16(Pv[BASE + 0], Pv[BASE + 1]), a1 = cvt_pk_bf16(Pv[BASE + 2], Pv[BASE + 3]); \
        unsigned b0_ = cvt_pk_bf16(Pv[BASE + 4], Pv[BASE + 5]), b1_ = cvt_pk_bf16(Pv[BASE + 6], Pv[BASE + 7]); \
        auto r0 = __builtin_amdgcn_permlane32_swap(a0, b0_, false, false); auto r1 = __builtin_amdgcn_permlane32_swap(a1, b1_, false, false); \
        u32x4 w_ = {r0[0], r1[0], r0[1], r1[1]}; OUT = *reinterpret_cast<bf16x8*>(&w_); } while (0)
            PK4(p0, 0, pa0); PK4(p0, 8, pa1); PK4(p1, 0, pa2); PK4(p1, 8, pa3);
#undef PK4
            if (__any(alpha < 1.f)) { if (hi == 0) al_l[r32] = alpha; asm volatile("s_waitcnt lgkmcnt(0)" ::: "memory");
#pragma unroll
                for (int r = 0; r < 16; ++r) { const float a = al_l[crow(r, hi)];
#pragma unroll
                    for (int d = 0; d < 4; ++d) o[d][r] *= a; } }
            const int vb = vb0 + buf * SHM_V;
            pv_one<0>(o[0], vb, pa0, pa1, pa2, pa3); pv_one<1>(o[1], vb, pa0, pa1, pa2, pa3); pv_one<2>(o[2], vb, pa0, pa1, pa2, pa3); pv_one<3>(o[3], vb, pa0, pa1, pa2, pa3);
        }
        asm volatile("s_waitcnt vmcnt(0)" ::: "memory");
        __syncthreads();
    }
#undef STAGE_T
#undef GLDS
    if (nact > 0) {
        if (hi == 0) li_l[r32] = l_reg; asm volatile("s_waitcnt lgkmcnt(0)" ::: "memory");
#pragma unroll
        for (int r = 0; r < 16; ++r) { const int orow = crow(r, hi); if (orow < orows) { const float rl = __builtin_amdgcn_rcpf(li_l[orow]);
#pragma unroll
            for (int d0 = 0; d0 < 4; ++d0) Orow0[(size_t)orow * 1024 + d0 * 32 + r32] = f2bf(o[d0][r] * rl); } }
    }
}
__device__ void attn_phase(const Params& P, unsigned char* lds) {
    unsigned char* ws = P.ws; const int tid = threadIdx.x, wid = tid >> 6, lane = tid & 63, r32 = lane & 31;
    const bf16_t* QB = (const bf16_t*)(ws + WS_QB); const bf16_t* KVB = (const bf16_t*)(ws + WS_KVB); const bf16_t* KPE = (const bf16_t*)(ws + WS_KPE); bf16_t* CAT = (bf16_t*)(ws + WS_CAT); const float* RT = (const float*)(ws + WS_ROPE);
    for (int pr = blockIdx.x; pr < 512; pr += gridDim.x) {
        const int c = pr & 255, rnd = pr >> 8, xcd = c & 7, slot = c >> 3, bh = rnd * 16 + xcd * 2 + (slot >> 4), x = slot & 15, b = bh >> 2, h = bh & 3;
#pragma unroll 1
        for (int s = 0; s < 2; ++s) { const int qb = s == 0 ? 31 - x : x; const int q0 = b * 8192 + qb * 256 + wid * 32;
            attn_unit(QB + (size_t)(q0 + r32) * 768 + h * 192, RT + (size_t)((q0 + r32) & 8191) * 64, KVB + (size_t)(b * 8192) * 1024 + h * 128, KPE + (size_t)(b * 8192) * 64,
                      CAT + (size_t)q0 * 1024 + 512 + h * 128, 32, 4 * qb + 4, 4 * qb + 1 + (wid >> 1), 64, lds); }
    }
    for (int su = blockIdx.x; su < 32; su += gridDim.x) { const int b = su >> 2, h = su & 3; const int q0 = TP + b * 16;
        attn_unit(QB + (size_t)(q0 + (r32 & 15)) * 768 + h * 192, RT + (size_t)(2048 + (r32 & 15)) * 64, KVB + (size_t)(TP + b * KVS) * 1024 + h * 128, KPE + (size_t)(TP + b * KVS) * 64,
                  CAT + (size_t)q0 * 1024 + 512 + h * 128, 16, 33, wid == 0 ? 33 : 0, 16, lds); }
}
}

__device__ void ln1_phase(const Params& P) {
    unsigned char* ws = P.ws; const int lane = threadIdx.x & 63; const int gw = blockIdx.x * 8 + (threadIdx.x >> 6), nw = gridDim.x * 8;
    const bf16_t* R1 = (const bf16_t*)(ws + WS_R1); bf16_t* H = (bf16_t*)(ws + WS_H); const float* g = P.in[16]; const float* bb = P.in[17];
    float gg[16], bv[16];
#pragma unroll
    for (int e = 0; e < 8; ++e) { gg[e] = g[lane * 8 + e]; gg[8 + e] = g[512 + lane * 8 + e]; bv[e] = bb[lane * 8 + e]; bv[8 + e] = bb[512 + lane * 8 + e]; }
    for (int t = gw; t < TOK; t += nw) {
        const u32x4 w0 = *(const u32x4*)(R1 + (size_t)t * 1024 + lane * 8), w1 = *(const u32x4*)(R1 + (size_t)t * 1024 + 512 + lane * 8);
        float x[16] = {blo(w0.x), bhi(w0.x), blo(w0.y), bhi(w0.y), blo(w0.z), bhi(w0.z), blo(w0.w), bhi(w0.w), blo(w1.x), bhi(w1.x), blo(w1.y), bhi(w1.y), blo(w1.z), bhi(w1.z), blo(w1.w), bhi(w1.w)};
        float s = 0.f;
#pragma unroll
        for (int e = 0; e < 16; ++e) s += x[e];
        const float mu = wsum(s) * (1.f / 1024.f); float q = 0.f;
#pragma unroll
        for (int e = 0; e < 16; ++e) { x[e] -= mu; q += x[e] * x[e]; }
        const float rstd = rsqrtf(wsum(q) * (1.f / 1024.f) + 1e-5f);
#pragma unroll
        for (int e = 0; e < 16; ++e) x[e] = x[e] * rstd * gg[e] + bv[e];
        u32x4 o0, o1; o0.x = cvt_pk_bf16(x[0], x[1]); o0.y = cvt_pk_bf16(x[2], x[3]); o0.z = cvt_pk_bf16(x[4], x[5]); o0.w = cvt_pk_bf16(x[6], x[7]);
        o1.x = cvt_pk_bf16(x[8], x[9]); o1.y = cvt_pk_bf16(x[10], x[11]); o1.z = cvt_pk_bf16(x[12], x[13]); o1.w = cvt_pk_bf16(x[14], x[15]);
        *(u32x4*)(H + (size_t)t * 1024 + lane * 8) = o0; *(u32x4*)(H + (size_t)t * 1024 + 512 + lane * 8) = o1;
    }
}
__device__ void ln2_phase(const Params& P) {
    const int lane = threadIdx.x & 63; const int gw = blockIdx.x * 8 + (threadIdx.x >> 6), nw = gridDim.x * 8;
    float* Y = P.out + O_YP; const float* g = P.in[22]; const float* bb = P.in[23];
    f32x4 gg[4], bv[4];
#pragma unroll
    for (int i = 0; i < 4; ++i) { gg[i] = *(const f32x4*)(g + i * 256 + lane * 4); bv[i] = *(const f32x4*)(bb + i * 256 + lane * 4); }
    for (int t = gw; t < TOK; t += nw) {
        float* yr = Y + (size_t)t * 1024; f32x4 x[4]; float s = 0.f;
#pragma unroll
        for (int i = 0; i < 4; ++i) { x[i] = *(const f32x4*)(yr + i * 256 + lane * 4); s += (x[i][0] + x[i][1]) + (x[i][2] + x[i][3]); }
        const float mu = wsum(s) * (1.f / 1024.f); float q = 0.f;
#pragma unroll
        for (int i = 0; i < 4; ++i) { x[i] = x[i] - mu; q += (x[i][0] * x[i][0] + x[i][1] * x[i][1]) + (x[i][2] * x[i][2] + x[i][3] * x[i][3]); }
        const float rstd = rsqrtf(wsum(q) * (1.f / 1024.f) + 1e-5f);
#pragma unroll
        for (int i = 0; i < 4; ++i) *(f32x4*)(yr + i * 256 + lane * 4) = x[i] * rstd * gg[i] + bv[i];
    }
}
__device__ void convact_phase(const Params& P, int rbase, int nrows) {
    unsigned char* ws = P.ws; const long gtid = blockIdx.x * 512L + threadIdx.x, gsz = gridDim.x * 512L;
    const bf16_t* UP = (const bf16_t*)(ws + WS_UPH); bf16_t* ACT = (bf16_t*)(ws + WS_ACTH);
    const float* wc = P.in[19]; const float* bc = P.in[20]; const float* st = P.in[4];
    const int rend = (rbase + nrows < TOK ? rbase + nrows : TOK) - rbase;
    for (long it = gtid; it < (long)rend * 352; it += gsz) {
        const int rl = (int)(it / 352), f = (int)(it % 352) * 8, t = rbase + rl;
        const bool samp = t >= TP; const int pos = samp ? (t & 15) : (t & 8191); const int sb = (t - TP) >> 4;
        float acc[2][8]; float cur[2][8];
#pragma unroll
        for (int part = 0; part < 2; ++part) {
            const int col = f + part * DFF;
            const f32x4 b0 = *(const f32x4*)(bc + col), b1 = *(const f32x4*)(bc + col + 4);
            float a[8] = {b0[0], b0[1], b0[2], b0[3], b1[0], b1[1], b1[2], b1[3]};
#pragma unroll
            for (int k = 0; k < 3; ++k) {
                const int pp = pos + k - 2; float x[8];
                if (pp >= 0) { const u32x4 w = *(const u32x4*)(UP + (size_t)(rl + k - 2) * DFF2 + col);
                    x[0] = blo(w.x); x[1] = bhi(w.x); x[2] = blo(w.y); x[3] = bhi(w.y); x[4] = blo(w.z); x[5] = bhi(w.z); x[6] = blo(w.w); x[7] = bhi(w.w); }
                else if (samp) { const float* sp = st + ((size_t)sb * 2 + (pos + k)) * DFF2 + col; const f32x4 s0 = *(const f32x4*)sp, s1 = *(const f32x4*)(sp + 4);
                    x[0] = s0[0]; x[1] = s0[1]; x[2] = s0[2]; x[3] = s0[3]; x[4] = s1[0]; x[5] = s1[1]; x[6] = s1[2]; x[7] = s1[3]; }
                else {
#pragma unroll
                    for (int e = 0; e < 8; ++e) x[e] = 0.f; }
                const f32x4 w0 = *(const f32x4*)(wc + (size_t)k * DFF2 + col), w1 = *(const f32x4*)(wc + (size_t)k * DFF2 + col + 4);
                const float wv[8] = {w0[0], w0[1], w0[2], w0[3], w1[0], w1[1], w1[2], w1[3]};
#pragma unroll
                for (int e = 0; e < 8; ++e) a[e] += wv[e] * x[e];
                if (k == 2) {
#pragma unroll
                    for (int e = 0; e < 8; ++e) cur[part][e] = x[e]; }
            }
#pragma unroll
            for (int e = 0; e < 8; ++e) acc[part][e] = a[e];
        }
        u32x4 o;
        o.x = cvt_pk_bf16(silu(acc[0][0]) * acc[1][0], silu(acc[0][1]) * acc[1][1]); o.y = cvt_pk_bf16(silu(acc[0][2]) * acc[1][2], silu(acc[0][3]) * acc[1][3]);
        o.z = cvt_pk_bf16(silu(acc[0][4]) * acc[1][4], silu(acc[0][5]) * acc[1][5]); o.w = cvt_pk_bf16(silu(acc[0][6]) * acc[1][6], silu(acc[0][7]) * acc[1][7]);
        *(u32x4*)(ACT + (size_t)rl * DFF + f) = o;
        const int jst = samp ? pos - 14 : pos - 8190;
        if (jst >= 0) { float* so = P.out + (samp ? O_FCS + ((size_t)sb * 2 + jst) * DFF2 : O_FCP + ((size_t)(t >> 13) * 2 + jst) * DFF2);
#pragma unroll
            for (int part = 0; part < 2; ++part) { *(f32x4*)(so + f + part * DFF) = (f32x4){cur[part][0], cur[part][1], cur[part][2], cur[part][3]};
                *(f32x4*)(so + f + part * DFF + 4) = (f32x4){cur[part][4], cur[part][5], cur[part][6], cur[part][7]}; } }
    }
}

constexpr int NPHASE = 14;
__global__ void __launch_bounds__(512, 2) mega_fwd(Params P) {
    extern __shared__ __attribute__((aligned(16))) unsigned char lds[];
    cg::grid_group grid = cg::this_grid();
    PG8_LAS unsigned char* ldsl = (PG8_LAS unsigned char*)lds;
    unsigned char* ws = P.ws; const int lo = P.ph_lo, hi = P.ph_hi; const int G = gridDim.x, bx = blockIdx.x;
#ifndef PHMASK
#define PHMASK 0xFFFF
#endif
#define IN(k) (((PHMASK >> (k)) & 1) && lo <= (k) && (k) < hi)
#define SEAM(k) do { if (IN(k) && IN((k) + 1)) grid.sync(); } while (0)
    if (IN(0)) p0_prologue(P, lds);
    SEAM(0);
    if (IN(1)) { pg8::Gemm g{(const bf16_t*)(ws + WS_XB), (const bf16_t*)(ws + WS_WIN), TOKP, NIN, 1024}; pg8::StaticOrder S; S.init(TOKP, NIN, G, bx);
        pg8::EpiPlain E{(bf16_t*)(ws + WS_PROJ), NIN, 4, 1.f}; pg8::gemm_phase<pg8::EpiPlain, pg8::StaticOrder, true, true>(ldsl, g, S, E); }
    SEAM(1);
    if (IN(2)) p2_token(P);
    SEAM(2);
    if (IN(3)) {
#ifndef NOQ
        { pg8::Gemm g{(const bf16_t*)(ws + WS_CQN), (const bf16_t*)(ws + WS_WUQ), TOKP, 768, 384}; pg8::StaticOrder S; S.init(TOKP, 768, G, bx);
          pg8::EpiPlain E{(bf16_t*)(ws + WS_QB), 768, 0, QSCALE}; pg8::gemm_phase<pg8::EpiPlain, pg8::StaticOrder, true, true>(ldsl, g, S, E); }
#endif
#ifndef NOKV
        { pg8::Gemm g{(const bf16_t*)(ws + WS_CKVN), (const bf16_t*)(ws + WS_WKV), KVRP, 1024, 256}; pg8::StaticOrder S; S.init(KVRP, 1024, G, bx);
          pg8::EpiPlain E{(bf16_t*)(ws + WS_KVB), 1024, 0, 1.f}; pg8::gemm_phase<pg8::EpiPlain, pg8::StaticOrder, true, true>(ldsl, g, S, E); }
#endif
#ifndef NOSP
        spatial_phase(P, lds);
#endif
    }
    SEAM(3);
    if (IN(4)) att::attn_phase(P, lds);
    SEAM(4);
    if (IN(5)) { pg8::Gemm g{(const bf16_t*)(ws + WS_CAT), (const bf16_t*)(ws + WS_WO), TOKP, 1024, 1024}; pg8::StaticOrder S; S.init(TOKP, 1024, G, bx);
        pg8::EpiWo E{(bf16_t*)(ws + WS_R1), P.in[0], P.in[1]}; pg8::gemm_phase<pg8::EpiWo, pg8::StaticOrder, true, true>(ldsl, g, S, E); }
    SEAM(5);
    if (IN(6)) ln1_phase(P);
    SEAM(6);
#pragma unroll 1
    for (int half = 0; half < 2; ++half) {
        const int rb = half * HROWS0, nr = half ? HROWS1 : HROWS0, pb = 7 + 3 * half;
        if (IN(pb)) { pg8::Gemm g{(const bf16_t*)(ws + WS_H) + (size_t)rb * 1024, (const bf16_t*)(ws + WS_WUP), nr, DFF2, 1024}; pg8::StaticOrder S; S.init(nr, DFF2, G, bx);
            pg8::EpiPlain E{(bf16_t*)(ws + WS_UPH), DFF2, 0, 1.f}; pg8::gemm_phase<pg8::EpiPlain, pg8::StaticOrder, true, true>(ldsl, g, S, E); }
        SEAM(pb);
        if (IN(pb + 1)) convact_phase(P, rb, nr);
        SEAM(pb + 1);
        if (IN(pb + 2)) { pg8::Gemm g{(const bf16_t*)(ws + WS_ACTH), (const bf16_t*)(ws + WS_WDN), nr, 1024, DFF}; pg8::StaticOrder S; S.init(nr, 1024, G, bx);
            pg8::EpiDown E{P.out + O_YP, (const bf16_t*)(ws + WS_H), rb}; pg8::gemm_phase<pg8::EpiDown, pg8::StaticOrder, true, true>(ldsl, g, S, E); }
        SEAM(pb + 2);
    }
    if (IN(13)) ln2_phase(P);
#undef IN
#undef SEAM
}

extern "C" void kernel_launch(void* const* d_in, const int* in_sizes, int n_in, void* d_out, int out_size, void* d_ws, size_t ws_size, hipStream_t stream) {
    static int grid_blocks = 0;
    if (grid_blocks == 0) {
        if (n_in != 24 || out_size != (int)O_END || ws_size < WS_END) { fprintf(stderr, "kernel_launch: unexpected shapes: n_in %d out %d ws %zu (need %zu)\n", n_in, out_size, ws_size, (size_t)WS_END); grid_blocks = -1; return; }
        int dev = 0, cus = 0, per_cu = 0;
        hipGetDevice(&dev); hipDeviceGetAttribute(&cus, hipDeviceAttributeMultiprocessorCount, dev);
        if (hipFuncSetAttribute((const void*)mega_fwd, hipFuncAttributeMaxDynamicSharedMemorySize, LDS_BYTES) != hipSuccess) { fprintf(stderr, "kernel_launch: hipFuncSetAttribute failed\n"); grid_blocks = -1; return; }
        if (hipOccupancyMaxActiveBlocksPerMultiprocessor(&per_cu, (const void*)mega_fwd, 512, LDS_BYTES) != hipSuccess || per_cu < 1) { fprintf(stderr, "kernel_launch: occupancy query gave %d\n", per_cu); per_cu = 1; }
        (void)hipGetLastError();
        grid_blocks = cus * 1;
    }
    if (grid_blocks < 0) return;
    Params p{};
    for (int i = 0; i < 24; ++i) p.in[i] = (const float*)d_in[i];
    p.out = (float*)d_out; p.ws = (unsigned char*)d_ws;
#if defined(MK_MULTI)
    for (int ph = 0; ph < NPHASE; ++ph) { p.ph_lo = ph; p.ph_hi = ph + 1; hipLaunchKernelGGL(mega_fwd, dim3(grid_blocks), dim3(512), LDS_BYTES, stream, p); }
#else
    p.ph_lo = 0; p.ph_hi = NPHASE;
    void* args[] = {&p};
    hipError_t e = hipLaunchCooperativeKernel((const void*)mega_fwd, dim3(grid_blocks), dim3(512), args, LDS_BYTES, stream);
    if (e != hipSuccess) fprintf(stderr, "kernel_launch: cooperative launch failed: %s (grid %d)\n", hipGetErrorString(e), grid_blocks);
#endif
}
```

```cpp
#include <hip/hip_runtime.h>
#include <hip/hip_cooperative_groups.h>
#include <cstdio>
#include <cstdint>
namespace cg = cooperative_groups;
namespace pg8 {
#define PG8_LAS __attribute__((address_space(3)))
typedef unsigned short bf16_t;
typedef short bf16x8 __attribute__((ext_vector_type(8)));
typedef float f32x4 __attribute__((ext_vector_type(4)));
typedef unsigned u32x4 __attribute__((ext_vector_type(4)));
constexpr int BM = 256, BK = 64, HALF = 128, HTB = HALF * BK * 2  , STAGE_BYTES = 8 * HTB, NXCD = 8, WGM = 8;

__host__ __device__ __forceinline__ int lds_byte(int r, int c) { const int st = (r >> 4) * 2 + (c >> 5), rr = r & 15, cc = c & 31, ob = rr * 64 + cc * 2; return st * 1024 + (ob ^ (((ob >> 9) & 1) << 5)); }
__host__ __device__ __forceinline__ void stage_rc(int b, int& R, int& C) { const int st = b / 1024, sb = b % 1024, swz = sb ^ (((sb >> 9) & 1) << 5); R = (st >> 1) * 16 + swz / 64; C = (st & 1) * 32 + (swz % 64) / 2; }
__host__ __device__ __forceinline__ int perm32(int rho) { const int n = rho >> 4, i = rho & 15; return 8 * (i >> 2) + 4 * n + (i & 3); }

struct Unit { int pm, pn; };
struct Gemm { const bf16_t* A; const bf16_t* Bt; int M, N, K; };

struct StaticOrder {
    int nM, nN, nwg, G, c;
    __host__ __device__ void init(int M, int N, int G_, int c_) { nM = M / BM; nN = N / BM; nwg = nM * nN; G = G_; c = c_; }
    __host__ __device__ bool next(int i, Unit& u) const {
        const long L = (long)i * G + c; if (L >= nwg) return false;
        int wgid = (int)L; { const int q = nwg / NXCD, r = nwg % NXCD, xcd = wgid % NXCD, off = wgid / NXCD; wgid = (xcd < r ? xcd * (q + 1) : r * (q + 1) + (xcd - r) * q) + off; }
        const int nig = WGM * nN, gid = wgid / nig, fm = gid * WGM, gsz = (nM - fm) < WGM ? (nM - fm) : WGM;
        u.pm = fm + ((wgid % nig) % gsz); u.pn = (wgid % nig) / gsz; return true;
    }
    __device__ __forceinline__ void a_ready(const Unit&) const {}
    __device__ __forceinline__ void done(const Unit&) const {}
};

__device__ __forceinline__ unsigned cvt_pk_bf16(float lo, float hi) { unsigned r; asm volatile("v_cvt_pk_bf16_f32 %0, %1, %2" : "=v"(r) : "v"(lo), "v"(hi)); return r; }
typedef float f32x2 __attribute__((ext_vector_type(2)));
template <class Epi, class Sched, bool ALIGN_EPI = false, bool SP2 = false>
__device__ __forceinline__ void gemm_phase(PG8_LAS unsigned char* lds, const Gemm g, const Sched& S, const Epi& E) {
    const int tid = threadIdx.x, wid = __builtin_amdgcn_readfirstlane(tid >> 6), lane = tid & 63, wr = wid >> 2, wc = wid & 3, fr = lane & 15, fq = lane >> 4;
    const int K = g.K, nt = K / BK;
    unsigned voffA[2], voffB[2];
#pragma unroll
    for (int i = 0; i < 2; ++i) { int R, C; stage_rc(tid * 16 + i * 8192, R, C); const int Rb = Epi::PERM ? ((R & ~31) + perm32(R & 31)) : R;
        voffA[i] = (unsigned)(R * K + C) * 2u; voffB[i] = (unsigned)(Rb * K + C) * 2u; }
    const size_t kstep = (size_t)(BK * 2);
    const size_t hstep = (size_t)HALF * K * 2;
    const size_t tstep = 2 * hstep;
    const unsigned ldsw = (unsigned)wid * 1024u;
    const int aoff = lds_byte(wr * 64 + fr, fq * 8), boff = lds_byte(wc * 32 + fr, fq * 8);
#define PG8_SA(b, h) (((b) * 2 + (h)) * HTB)
#define PG8_SB(b, h) ((4 + (b) * 2 + (h)) * HTB)
#define PG8_STAGE(bufoff, gbase, voff) do { _Pragma("unroll") for (int _i = 0; _i < 2; ++_i) \
        __builtin_amdgcn_global_load_lds((const unsigned*)((const char*)(gbase) + (voff)[_i]), (PG8_LAS unsigned*)(lds + (bufoff) + ldsw + _i * 8192), 16, 0, 0); } while (0)
#define PG8_LDA(dst, b, h) do { _Pragma("unroll") for (int m = 0; m < 4; ++m) _Pragma("unroll") for (int k = 0; k < 2; ++k) dst[m][k] = *(const PG8_LAS bf16x8*)(lds + PG8_SA(b, h) + aoff + m * 2048 + k * 1024); } while (0)
#define PG8_LDB(dst, b, h) do { _Pragma("unroll") for (int n = 0; n < 2; ++n) _Pragma("unroll") for (int k = 0; k < 2; ++k) dst[n][k] = *(const PG8_LAS bf16x8*)(lds + PG8_SB(b, h) + boff + n * 2048 + k * 1024); } while (0)
#define PG8_MMA(ai, bj, At, Bt) do { __builtin_amdgcn_s_setprio(1); _Pragma("unroll") for (int m = 0; m < 4; ++m) _Pragma("unroll") for (int n = 0; n < 2; ++n) _Pragma("unroll") for (int k = 0; k < 2; ++k) \
        acc[ai][bj][m][n] = __builtin_amdgcn_mfma_f32_16x16x32_bf16(Bt[n][k], At[m][k], acc[ai][bj][m][n], 0, 0, 0); __builtin_amdgcn_s_setprio(0); } while (0)
#define PG8_WAIT_V(n) asm volatile("s_waitcnt vmcnt(" #n ")" ::: "memory")
#define PG8_WAIT_L(n) asm volatile("s_waitcnt lgkmcnt(" #n ")" ::: "memory")
#define PG8_BAR __builtin_amdgcn_s_barrier()
#define PG8_SCHED __builtin_amdgcn_sched_barrier(0)
    Unit cur, nxt; int ui = 0;
    if (!S.next(0, cur)) return;
    f32x4 acc[2][2][4][2];
#pragma unroll
    for (int a = 0; a < 2; ++a)
#pragma unroll
        for (int b = 0; b < 2; ++b)
#pragma unroll
            for (int m = 0; m < 4; ++m)
#pragma unroll
                for (int n = 0; n < 2; ++n) acc[a][b][m][n] = (f32x4){0.f, 0.f, 0.f, 0.f};
    bf16x8 At[4][2], B0[2][2], B1[2][2];
    const char* cA = (const char*)g.A + (size_t)cur.pm * tstep; const char* cB = (const char*)g.Bt + (size_t)cur.pn * tstep;
    S.a_ready(cur);
    if constexpr (SP2) {
        PG8_STAGE(PG8_SB(0, 0), cB, voffB); PG8_STAGE(PG8_SB(0, 1), cB + hstep, voffB); PG8_STAGE(PG8_SA(0, 0), cA, voffA); PG8_STAGE(PG8_SA(0, 1), cA + hstep, voffA);
        if (wr == 1) PG8_BAR;
        PG8_WAIT_V(2); PG8_BAR;
        PG8_STAGE(PG8_SB(1, 0), cB + kstep, voffB); PG8_STAGE(PG8_SA(1, 0), cA + kstep, voffA); PG8_STAGE(PG8_SB(1, 1), cB + hstep + kstep, voffB);
        PG8_WAIT_V(6); PG8_BAR;
    } else {
        PG8_STAGE(PG8_SB(0, 0), cB, voffB); PG8_STAGE(PG8_SA(0, 0), cA, voffA); PG8_STAGE(PG8_SB(0, 1), cB + hstep, voffB); PG8_STAGE(PG8_SA(0, 1), cA + hstep, voffA);
        if (wr == 1) PG8_BAR;
        PG8_WAIT_V(4); PG8_BAR;
        PG8_STAGE(PG8_SB(1, 0), cB + kstep, voffB); PG8_STAGE(PG8_SA(1, 0), cA + kstep, voffA); PG8_STAGE(PG8_SB(1, 1), cB + hstep + kstep, voffB);
        PG8_WAIT_V(6); PG8_BAR;
    }
    for (;;) {
        const bool has_next = S.next(ui + 1, nxt);
        const char* nA = has_next ? (const char*)g.A + (size_t)nxt.pm * tstep : cA; const char* nB = has_next ? (const char*)g.Bt + (size_t)nxt.pn * tstep : cB;
        for (int t = 0; t < nt; t += 2) {
            const bool last = (t == nt - 2);
            const char* a1 = cA + (size_t)(t + 1) * kstep;
            const char* a2 = last ? nA : cA + (size_t)(t + 2) * kstep; const char* b2 = last ? nB : cB + (size_t)(t + 2) * kstep;
            const char* a3 = a2 + kstep; const char* b3 = b2 + kstep;
            if (last && has_next) S.a_ready(nxt);
            if constexpr (SP2) {
            PG8_LDB(B0, 0, 0); PG8_LDB(B1, 0, 1); PG8_SCHED; PG8_LDA(At, 0, 0); PG8_STAGE(PG8_SA(1, 1), a1 + hstep, voffA);
            PG8_WAIT_V(8); PG8_WAIT_L(0); PG8_BAR; PG8_MMA(0, 0, At, B0); PG8_MMA(0, 1, At, B1); PG8_BAR; PG8_SCHED;
            PG8_LDA(At, 0, 1); PG8_STAGE(PG8_SB(0, 0), b2, voffB); PG8_STAGE(PG8_SB(0, 1), b2 + hstep, voffB); PG8_STAGE(PG8_SA(0, 0), a2, voffA);
            PG8_WAIT_V(8); PG8_WAIT_L(0); PG8_BAR; PG8_MMA(1, 0, At, B0); PG8_MMA(1, 1, At, B1); PG8_BAR; PG8_SCHED;
            PG8_LDB(B0, 1, 0); PG8_LDB(B1, 1, 1); PG8_SCHED; PG8_LDA(At, 1, 0); PG8_STAGE(PG8_SA(0, 1), a2 + hstep, voffA);
            PG8_WAIT_V(8); PG8_WAIT_L(0); PG8_BAR; PG8_MMA(0, 0, At, B0); PG8_MMA(0, 1, At, B1); PG8_BAR; PG8_SCHED;
            PG8_LDA(At, 1, 1); PG8_STAGE(PG8_SB(1, 0), b3, voffB); PG8_STAGE(PG8_SB(1, 1), b3 + hstep, voffB); PG8_STAGE(PG8_SA(1, 0), a3, voffA);
            PG8_WAIT_V(8); PG8_WAIT_L(0); PG8_BAR; PG8_MMA(1, 0, At, B0); PG8_MMA(1, 1, At, B1); PG8_BAR; PG8_SCHED;
            } else {
            PG8_LDB(B0, 0, 0); PG8_SCHED; PG8_LDA(At, 0, 0); PG8_STAGE(PG8_SA(1, 1), a1 + hstep, voffA);
            PG8_WAIT_L(8); PG8_BAR; PG8_WAIT_L(0); PG8_MMA(0, 0, At, B0); PG8_BAR; PG8_SCHED;
            PG8_LDB(B1, 0, 1); PG8_STAGE(PG8_SB(0, 0), b2, voffB);
            PG8_BAR; PG8_WAIT_L(0); PG8_MMA(0, 1, At, B1); PG8_BAR;
            PG8_LDA(At, 0, 1); PG8_STAGE(PG8_SA(0, 0), a2, voffA);
            PG8_BAR; PG8_WAIT_L(0); PG8_MMA(1, 0, At, B0); PG8_BAR; PG8_SCHED;
            PG8_STAGE(PG8_SB(0, 1), b2 + hstep, voffB);
            PG8_WAIT_V(6); PG8_BAR; PG8_MMA(1, 1, At, B1); PG8_BAR;
            PG8_LDB(B0, 1, 0); PG8_SCHED; PG8_LDA(At, 1, 0); PG8_STAGE(PG8_SA(0, 1), a2 + hstep, voffA);
            PG8_WAIT_L(8); PG8_BAR; PG8_WAIT_L(0); PG8_MMA(0, 0, At, B0); PG8_BAR; PG8_SCHED;
            PG8_LDB(B1, 1, 1); PG8_STAGE(PG8_SB(1, 0), b3, voffB);
            PG8_BAR; PG8_WAIT_L(0); PG8_MMA(0, 1, At, B1); PG8_BAR;
            PG8_LDA(At, 1, 1); PG8_STAGE(PG8_SA(1, 0), a3, voffA);
            PG8_BAR; PG8_WAIT_L(0); PG8_MMA(1, 0, At, B0); PG8_BAR; PG8_SCHED;
            PG8_STAGE(PG8_SB(1, 1), b3 + hstep, voffB);
            PG8_WAIT_V(6); PG8_BAR; PG8_MMA(1, 1, At, B1); PG8_BAR;
            }
        }
        if constexpr (ALIGN_EPI) { if (wr == 0) PG8_BAR; }
        if constexpr (!Epi::AFTER_DRAIN) { E(acc, cur, wr, wc, fr, fq); S.done(cur); }
        if (!has_next) break;
#pragma unroll
        for (int a = 0; a < 2; ++a)
#pragma unroll
            for (int b = 0; b < 2; ++b)
#pragma unroll
                for (int m = 0; m < 4; ++m)
#pragma unroll
                    for (int n = 0; n < 2; ++n) acc[a][b][m][n] = (f32x4){0.f, 0.f, 0.f, 0.f};
        cur = nxt; cA = nA; cB = nB; ++ui;
        if constexpr (ALIGN_EPI) { if (wr == 1) PG8_BAR; }
    }
    PG8_WAIT_V(0);
    if constexpr (!ALIGN_EPI) { if (wr == 0) PG8_BAR; }
    PG8_BAR;
    if constexpr (Epi::AFTER_DRAIN) { E.fused(acc, cur, wr, wc, fr, fq, lds, wid, lane); S.done(cur); }
#undef PG8_SA
#undef PG8_SB
#undef PG8_STAGE
#undef PG8_LDA
#undef PG8_LDB
#undef PG8_MMA
#undef PG8_WAIT_V
#undef PG8_WAIT_L
#undef PG8_BAR
#undef PG8_SCHED
}
}

using pg8::bf16_t; using pg8::bf16x8; using pg8::f32x4; using pg8::u32x4; using pg8::cvt_pk_bf16;
typedef short s16x4 __attribute__((ext_vector_type(4)));
typedef float f32x16 __attribute__((ext_vector_type(16)));
constexpr int TP = 65536, TS = 128, TOK = TP + TS, TOKP = 65792;
constexpr int KVS = 2064, KVR = TP + 8 * KVS, KVRP = 82176;
constexpr int NIN = 1792, DFF = 2816, DFF2 = 5632;
constexpr float ALPHA = 1.189207115002721f;
constexpr float QSCALE = 0.07216878364870323f * 1.4426950408889634f;
constexpr long O_YP = 0, O_CKVP = 67239936L, O_KPEP = 84017152L, O_FCP = 88211456L, O_CKVS = 88301568L, O_KPES = 88334336L, O_GVS = 88342528L, O_FCS = 88408064L, O_END = 88498176L;
constexpr int LDS_BYTES = 131072;
constexpr size_t al256(size_t x) { return (x + 255) / 256 * 256; }
constexpr size_t WS_WIN = 0;
constexpr size_t WS_WUQ = WS_WIN + al256((size_t)NIN * 1024 * 2);
constexpr size_t WS_WKV = WS_WUQ + al256((size_t)768 * 384 * 2);
constexpr size_t WS_WO  = WS_WKV + al256((size_t)1024 * 256 * 2);
constexpr size_t WS_WUP = WS_WO + al256((size_t)1024 * 1024 * 2);
constexpr size_t WS_WDN = WS_WUP + al256((size_t)DFF2 * 1024 * 2);
constexpr size_t WS_WSP = WS_WDN + al256((size_t)1024 * DFF * 2);
constexpr size_t WS_WSS = WS_WSP + al256((size_t)4 * 128 * 128 * 2);
constexpr size_t WS_ROPE = WS_WSS + al256((size_t)4 * 128 * 128 * 2);
constexpr size_t WS_PROJ = WS_ROPE + al256((size_t)8192 * 32 * 8);
constexpr size_t WS_H = WS_PROJ;
constexpr size_t WS_XB = WS_PROJ + al256((size_t)TOKP * NIN * 2);
constexpr size_t WS_VN = WS_XB;
constexpr size_t WS_CQN = WS_VN + al256((size_t)TOKP * 512 * 2);
constexpr size_t WS_CKVN = WS_XB + al256((size_t)TOKP * 1024 * 2);
constexpr size_t WS_KPE = WS_CKVN + al256((size_t)KVRP * 256 * 2);
constexpr size_t WS_QB = WS_KPE + al256((size_t)KVRP * 64 * 2);
constexpr size_t WS_KVB = WS_QB + al256((size_t)TOKP * 768 * 2);
constexpr size_t WS_R1 = WS_KVB;
constexpr size_t WS_CAT = WS_KVB + al256((size_t)KVRP * 1024 * 2);
constexpr size_t WS_END = WS_CAT + al256((size_t)TOKP * 1024 * 2);
constexpr size_t WS_ACT = WS_XB;
constexpr size_t WS_BND = WS_ACT + al256((size_t)TOKP * DFF * 2);
constexpr size_t WS_UPS = WS_BND + al256((size_t)1024 * 4 * DFF2 * 2);
static_assert(WS_UPS + (size_t)128 * DFF2 * 2 <= WS_END, "FFN overlay does not fit");
static_assert(WS_CQN + (size_t)TOKP * 384 * 2 <= WS_CKVN, "VN+CQN overlay does not fit");

struct Params { const float* in[24]; float* out; unsigned char* ws; int ph_lo, ph_hi; };

__device__ __forceinline__ float bf2f(unsigned short h) { return __uint_as_float((unsigned)h << 16); }
__device__ __forceinline__ unsigned short f2bf(float f) { return (unsigned short)(cvt_pk_bf16(f, 0.f) & 0xffffu); }
__device__ __forceinline__ float blo(unsigned w) { return __uint_as_float(w << 16); }
__device__ __forceinline__ float bhi(unsigned w) { return __uint_as_float(w & 0xffff0000u); }
__device__ __forceinline__ float wsum(float v) {
#pragma unroll
    for (int o = 32; o > 0; o >>= 1) v += __shfl_xor(v, o);
    return v; }
__device__ __forceinline__ float gelu_tanh(float x) {
    const float u = 0.7978845608028654f * (x + 0.044715f * x * x * x);
    const float t = __builtin_amdgcn_exp2f(-2.885390081777927f * u);
    return x * __builtin_amdgcn_rcpf(1.f + t); }
__device__ __forceinline__ float silu(float x) { return x * __builtin_amdgcn_rcpf(1.f + __builtin_amdgcn_exp2f(-1.4426950408889634f * x)); }
__device__ __forceinline__ int rope_phys(int Ld) { const int nn = Ld >> 5, i = Ld & 31; return (i >> 4) * 32 + ((i & 15) >> 2) * 8 + nn * 4 + (i & 3); }
__device__ __forceinline__ int tok_pos(int row) { return row < TP ? (row & 8191) : (2048 + (row & 15)); }

namespace pg8 {
struct EpiPlain {
    static constexpr bool PERM = true, AFTER_DRAIN = false;
    bf16_t* O; int ldc; int gelu_tiles; float scale;
    __device__ __forceinline__ void operator()(const f32x4 (&acc)[2][2][4][2], const Unit& u, int wr, int wc, int fr, int fq) const {
        const int row0 = u.pm * BM + wr * 64 + fr, col0 = u.pn * BM + wc * 32 + 8 * fq; const bool g = u.pn < gelu_tiles;
#pragma unroll
        for (int ai = 0; ai < 2; ++ai)
#pragma unroll
            for (int m = 0; m < 4; ++m) { bf16_t* rowp = O + (size_t)(row0 + ai * HALF + m * 16) * ldc + col0;
#pragma unroll
                for (int bj = 0; bj < 2; ++bj) { f32x4 v0 = acc[ai][bj][m][0], v1 = acc[ai][bj][m][1];
                    if (g) {
#pragma unroll
                        for (int e = 0; e < 4; ++e) { v0[e] = gelu_tanh(v0[e]); v1[e] = gelu_tanh(v1[e]); } }
                    v0 = v0 * scale; v1 = v1 * scale;
                    u32x4 w; w.x = cvt_pk_bf16(v0[0], v0[1]); w.y = cvt_pk_bf16(v0[2], v0[3]); w.z = cvt_pk_bf16(v1[0], v1[1]); w.w = cvt_pk_bf16(v1[2], v1[3]);
                    *(u32x4*)(rowp + bj * HALF) = w; } }
    }
};
struct EpiQ {
    static constexpr bool PERM = true, AFTER_DRAIN = false;
    bf16_t* O; const float* rope;
    __device__ __forceinline__ void operator()(const f32x4 (&acc)[2][2][4][2], const Unit& u, int wr, int wc, int fr, int fq) const {
        const int row0 = u.pm * BM + wr * 64 + fr, col0 = u.pn * BM + wc * 32 + 8 * fq;
#pragma unroll
        for (int ai = 0; ai < 2; ++ai)
#pragma unroll
            for (int m = 0; m < 4; ++m) { const int row = row0 + ai * HALF + m * 16; bf16_t* rowp = O + (size_t)row * 768 + col0; const int pos = tok_pos(row);
#pragma unroll
                for (int bj = 0; bj < 2; ++bj) { f32x4 v0 = acc[ai][bj][m][0], v1 = acc[ai][bj][m][1];
                    const int within = (u.pn * BM + bj * HALF + wc * 32) % 192;
                    if (within >= 128) { const int i0 = ((within - 128) >> 5) * 16 + fq * 4; const float* rp = rope + ((size_t)pos * 32 + i0) * 2;
                        const f32x4 c01 = *(const f32x4*)rp, c23 = *(const f32x4*)(rp + 4);
                        const float cs[4] = {c01[0], c01[2], c23[0], c23[2]}, sn[4] = {c01[1], c01[3], c23[1], c23[3]};
#pragma unroll
                        for (int e = 0; e < 4; ++e) { const float x1 = v0[e], x2 = v1[e]; v0[e] = x1 * cs[e] - x2 * sn[e]; v1[e] = x2 * cs[e] + x1 * sn[e]; } }
                    v0 = v0 * QSCALE; v1 = v1 * QSCALE;
                    u32x4 w; w.x = cvt_pk_bf16(v0[0], v0[1]); w.y = cvt_pk_bf16(v0[2], v0[3]); w.z = cvt_pk_bf16(v1[0], v1[1]); w.w = cvt_pk_bf16(v1[2], v1[3]);
                    *(u32x4*)(rowp + bj * HALF) = w; }
                __builtin_amdgcn_sched_barrier(0); }
    }
};
struct EpiWo {
    static constexpr bool PERM = true, AFTER_DRAIN = false;
    bf16_t* O; const float* xp; const float* xs;
    __device__ __forceinline__ void operator()(const f32x4 (&acc)[2][2][4][2], const Unit& u, int wr, int wc, int fr, int fq) const {
        const int row0 = u.pm * BM + wr * 64 + fr, col0 = u.pn * BM + wc * 32 + 8 * fq;
#pragma unroll
        for (int ai = 0; ai < 2; ++ai)
#pragma unroll
            for (int m = 0; m < 4; ++m) { const int row = row0 + ai * HALF + m * 16; if (row >= TOK) continue;
                const float* xr = (row < TP ? xp + (size_t)row * 1024 : xs + (size_t)(row - TP) * 1024) + col0; bf16_t* rowp = O + (size_t)row * 1024 + col0;
#pragma unroll
                for (int bj = 0; bj < 2; ++bj) { const f32x4 a = *(const f32x4*)(xr + bj * HALF), b = *(const f32x4*)(xr + bj * HALF + 4);
                    const f32x4 v0 = acc[ai][bj][m][0] + a * ALPHA, v1 = acc[ai][bj][m][1] + b * ALPHA;
                    u32x4 w; w.x = cvt_pk_bf16(v0[0], v0[1]); w.y = cvt_pk_bf16(v0[2], v0[3]); w.z = cvt_pk_bf16(v1[0], v1[1]); w.w = cvt_pk_bf16(v1[2], v1[3]);
                    *(u32x4*)(rowp + bj * HALF) = w; } }
    }
};
struct EpiDown {
    static constexpr bool PERM = true, AFTER_DRAIN = false;
    float* Y; const bf16_t* H;
    __device__ __forceinline__ void operator()(const f32x4 (&acc)[2][2][4][2], const Unit& u, int wr, int wc, int fr, int fq) const {
        const int row0 = u.pm * BM + wr * 64 + fr, col0 = u.pn * BM + wc * 32 + 8 * fq;
#pragma unroll
        for (int ai = 0; ai < 2; ++ai)
#pragma unroll
            for (int m = 0; m < 4; ++m) { const int row = row0 + ai * HALF + m * 16; if (row >= TOK) continue;
                const bf16_t* hr = H + (size_t)row * 1024 + col0; float* yr = Y + (size_t)row * 1024 + col0;
#pragma unroll
                for (int bj = 0; bj < 2; ++bj) { const u32x4 hw = *(const u32x4*)(hr + bj * HALF);
                    f32x4 v0 = acc[ai][bj][m][0], v1 = acc[ai][bj][m][1];
                    v0[0] += ALPHA * blo(hw.x); v0[1] += ALPHA * bhi(hw.x); v0[2] += ALPHA * blo(hw.y); v0[3] += ALPHA * bhi(hw.y);
                    v1[0] += ALPHA * blo(hw.z); v1[1] += ALPHA * bhi(hw.z); v1[2] += ALPHA * blo(hw.w); v1[3] += ALPHA * bhi(hw.w);
                    *(f32x4*)(yr + bj * HALF) = v0; *(f32x4*)(yr + bj * HALF + 4) = v1; } }
    }
};
__device__ __forceinline__ float dpp_ror1(float v) { return __int_as_float(__builtin_amdgcn_update_dpp(0, __float_as_int(v), 0x121, 0xF, 0xF, false)); }
__device__ __forceinline__ float dpp_ror2(float v) { return __int_as_float(__builtin_amdgcn_update_dpp(0, __float_as_int(v), 0x122, 0xF, 0xF, false)); }
struct EpiUpConv {
    static constexpr bool PERM = true, AFTER_DRAIN = false;
    bf16_t* ACT; bf16_t* BND; bf16_t* UPS; const float* wcv; const float* bcv;
    __device__ __forceinline__ void operator()(const f32x4 (&acc)[2][2][4][2], const Unit& u, int wr, int wc, int fr, int fq) const {
        const int f0 = u.pn * 128 + wc * 32 + 8 * fq;
        if (u.pm == 256) {
#pragma unroll
            for (int m = 0; m < 4; ++m) { const int row = wr * 64 + m * 16 + fr;
#pragma unroll
                for (int bj = 0; bj < 2; ++bj) { const f32x4 v0 = acc[0][bj][m][0], v1 = acc[0][bj][m][1]; u32x4 w;
                    w.x = cvt_pk_bf16(v0[0], v0[1]); w.y = cvt_pk_bf16(v0[2], v0[3]); w.z = cvt_pk_bf16(v1[0], v1[1]); w.w = cvt_pk_bf16(v1[2], v1[3]);
                    *(u32x4*)((char*)UPS + ((unsigned)row * 5632u + (unsigned)(bj * 2816 + f0)) * 2u) = w; } }
            return;
        }
#pragma unroll
        for (int ai = 0; ai < 2; ++ai) {
            const int slab = u.pm * 4 + ai * 2 + wr;
            if (fr < 2 || fr >= 14) { const int m = fr < 2 ? 0 : 3; const int ri = fr < 2 ? fr : fr - 12;
#pragma unroll
                for (int bj = 0; bj < 2; ++bj) { const f32x4 v0 = fr < 2 ? acc[ai][bj][0][0] : acc[ai][bj][3][0], v1 = fr < 2 ? acc[ai][bj][0][1] : acc[ai][bj][3][1]; u32x4 w;
                    w.x = cvt_pk_bf16(v0[0], v0[1]); w.y = cvt_pk_bf16(v0[2], v0[3]); w.z = cvt_pk_bf16(v1[0], v1[1]); w.w = cvt_pk_bf16(v1[2], v1[3]);
                    *(u32x4*)((char*)BND + ((unsigned)(slab * 4 + ri) * 5632u + (unsigned)(bj * 2816 + f0)) * 2u) = w; }
                (void)m; }
            const bool g1 = fr >= 1, g2 = fr >= 2;
#pragma unroll
            for (int n = 0; n < 2; ++n) {
                unsigned pk[4][2];
                float aprev[4];
#pragma unroll
                for (int e = 0; e < 4; ++e) {
                    const char* wb = (const char*)wcv + (unsigned)(f0 + 4 * n + e) * 4u; const char* bbp = (const char*)bcv + (unsigned)(f0 + 4 * n + e) * 4u;
                    float cv[2][4];
#pragma unroll
                    for (int bj = 0; bj < 2; ++bj) {
                        const float w0 = *(const float*)(wb + bj * 2816 * 4), w1 = *(const float*)(wb + (5632 + bj * 2816) * 4), w2 = *(const float*)(wb + (2 * 5632 + bj * 2816) * 4), bb = *(const float*)(bbp + bj * 2816 * 4);
                        const float v0 = acc[ai][bj][0][n][e], v1 = acc[ai][bj][1][n][e], v2 = acc[ai][bj][2][n][e], v3 = acc[ai][bj][3][n][e];
                        const float a0 = dpp_ror1(v0), a1 = dpp_ror1(v1), a2 = dpp_ror1(v2), a3 = dpp_ror1(v3);
                        const float c0 = dpp_ror2(v0), c1 = dpp_ror2(v1), c2 = dpp_ror2(v2), c3 = dpp_ror2(v3);
                        cv[bj][0] = bb + w2 * v0 + w1 * a0 + w0 * c0;
                        cv[bj][1] = bb + w2 * v1 + w1 * (g1 ? a1 : a0) + w0 * (g2 ? c1 : c0);
                        cv[bj][2] = bb + w2 * v2 + w1 * (g1 ? a2 : a1) + w0 * (g2 ? c2 : c1);
                        cv[bj][3] = bb + w2 * v3 + w1 * (g1 ? a3 : a2) + w0 * (g2 ? c3 : c2); }
#pragma unroll
                    for (int m = 0; m < 4; ++m) { const float a = cv[0][m]; const float r = a * __builtin_amdgcn_rcpf(1.f + __builtin_amdgcn_exp2f(-1.4426950408889634f * a)) * cv[1][m];
                        if (e & 1) pk[m][e >> 1] = cvt_pk_bf16(aprev[m], r); else aprev[m] = r; }
                    __builtin_amdgcn_sched_barrier(0);
                }
#pragma unroll
                for (int m = 0; m < 4; ++m) { if (m == 0 && fr < 2) continue;
                    const int row = u.pm * BM + ai * HALF + wr * 64 + m * 16 + fr;
                    unsigned* dst = (unsigned*)((char*)ACT + ((unsigned)row * 2816u + (unsigned)(f0 + 4 * n)) * 2u);
                    typedef unsigned u32x2 __attribute__((ext_vector_type(2)));
                    *(u32x2*)dst = (u32x2){pk[m][0], pk[m][1]}; }
                __builtin_amdgcn_sched_barrier(0);
            }
        }
    }
};
}

__device__ void transpose_job(const float* __restrict__ src, int K, int N, bf16_t* __restrict__ dst, int mode, int rowoff, float* tile) {
    const int tid = threadIdx.x, ntn = N / 64, ntot = (K / 64) * ntn;
    for (int tix = blockIdx.x; tix < ntot; tix += gridDim.x) {
        const int kt = tix / ntn, nt = tix % ntn;
        __syncthreads();
#pragma unroll
        for (int i = 0; i < 8; ++i) { const int r = (tid >> 6) + 8 * i, c = tid & 63; tile[r * 65 + c] = src[(size_t)(kt * 64 + r) * N + nt * 64 + c]; }
        __syncthreads();
        const int nn = tid >> 3, kk = (tid & 7) * 8, n = nt * 64 + nn; int drow = n;
        if (mode == 1) { const int h = n / 192, d = n % 192; drow = d < 128 ? n : h * 192 + 128 + rope_phys(d - 128); }
        if (mode == 2) { const int part = n / DFF, f = n % DFF; drow = (f >> 7) * 256 + part * 128 + (f & 127); }
        float v[8];
#pragma unroll
        for (int e = 0; e < 8; ++e) v[e] = tile[(kk + e) * 65 + nn];
        u32x4 w; w.x = cvt_pk_bf16(v[0], v[1]); w.y = cvt_pk_bf16(v[2], v[3]); w.z = cvt_pk_bf16(v[4], v[5]); w.w = cvt_pk_bf16(v[6], v[7]);
        *(u32x4*)(dst + (size_t)(drow + rowoff) * K + kt * 64 + kk) = w;
    }
}
__device__ void p0_prologue(const Params& P, unsigned char* lds) {
    const int tid = threadIdx.x; const long gtid = blockIdx.x * 512L + tid, gsz = gridDim.x * 512L;
    unsigned char* ws = P.ws;
    {
        bf16_t* XB = (bf16_t*)(ws + WS_XB); const long n8 = (long)TOKP * 1024 / 8;
        for (long i = gtid; i < n8; i += gsz) { const long e = i * 8, row = e >> 10; u32x4 w = {0u, 0u, 0u, 0u};
            if (row < TOK) { const float* s = row < TP ? P.in[0] + e : P.in[1] + (e - (long)TP * 1024);
                const f32x4 a = *(const f32x4*)s, b = *(const f32x4*)(s + 4);
                w.x = cvt_pk_bf16(a[0], a[1]); w.y = cvt_pk_bf16(a[2], a[3]); w.z = cvt_pk_bf16(b[0], b[1]); w.w = cvt_pk_bf16(b[2], b[3]); }
            *(u32x4*)(XB + e) = w; }
    }
    {
        bf16_t* CK = (bf16_t*)(ws + WS_CKVN); const long n8 = 8L * 2048 * 256 / 8;
        for (long i = gtid; i < n8; i += gsz) { const long e = i * 8; const int r = (int)(e >> 8), c = (int)(e & 255), b = r >> 11, p = r & 2047;
            const float* s = P.in[2] + e; const f32x4 a = *(const f32x4*)s, bb = *(const f32x4*)(s + 4); u32x4 w;
            w.x = cvt_pk_bf16(a[0], a[1]); w.y = cvt_pk_bf16(a[2], a[3]); w.z = cvt_pk_bf16(bb[0], bb[1]); w.w = cvt_pk_bf16(bb[2], bb[3]);
            *(u32x4*)(CK + (size_t)(TP + b * KVS + p) * 256 + c) = w; }
        for (long i = gtid; i < (long)(KVRP - KVR) * 256; i += gsz) CK[(size_t)KVR * 256 + i] = 0;
        bf16_t* KP = (bf16_t*)(ws + WS_KPE);
        for (long i = gtid; i < 8L * 2048 * 64; i += gsz) { const int r = (int)(i >> 6), d = (int)(i & 63), b = r >> 11, p = r & 2047;
            KP[(size_t)(TP + b * KVS + p) * 64 + rope_phys(d)] = f2bf(P.in[3][i]); }
        for (long i = gtid; i < (long)(KVRP - KVR) * 64; i += gsz) KP[(size_t)KVR * 64 + i] = 0;
    }
    {
        float* RT = (float*)(ws + WS_ROPE);
        for (long i = gtid; i < 8192L * 32; i += gsz) { const int pos = (int)(i >> 5), k = (int)(i & 31);
            const float invf = exp2f(-(float)k * (13.287712379549449f / 32.f)); const float ang = (float)pos * invf;
            double rev = (double)ang * 0.15915494309189535; rev -= floor(rev); const float fr = (float)rev;
            RT[i * 2] = __builtin_amdgcn_cosf(fr); RT[i * 2 + 1] = __builtin_amdgcn_sinf(fr); }
    }
    {
        bf16_t* WP = (bf16_t*)(ws + WS_WSP); bf16_t* WS_ = (bf16_t*)(ws + WS_WSS); const float* w_s = P.in[8];
        for (long i = gtid; i < 4L * 128 * 128; i += gsz) { const int h = (int)(i >> 14), r = (int)(i >> 7) & 127, c = (int)i & 127;
            WP[i] = ((c >> 6) <= (r >> 6)) ? f2bf(w_s[i]) : (bf16_t)0;
            WS_[i] = ((r >> 4) == (c >> 4)) ? f2bf(w_s[h * 16384 + (r & 15) * 128 + (c & 15)]) : (bf16_t)0; }
        bf16_t* WI = (bf16_t*)(ws + WS_WIN);
        for (long i = gtid; i < 64L * 1024; i += gsz) WI[(size_t)1728 * 1024 + i] = 0;
    }
    float* tile = (float*)lds;
    transpose_job(P.in[5], 1024, 1728, (bf16_t*)(ws + WS_WIN), 0, 0, tile);
    transpose_job(P.in[11], 384, 768, (bf16_t*)(ws + WS_WUQ), 1, 0, tile);
    transpose_job(P.in[13], 256, 512, (bf16_t*)(ws + WS_WKV), 0, 0, tile);
    transpose_job(P.in[14], 256, 512, (bf16_t*)(ws + WS_WKV), 0, 512, tile);
    transpose_job(P.in[15], 1024, 1024, (bf16_t*)(ws + WS_WO), 0, 0, tile);
    transpose_job(P.in[18], 1024, DFF2, (bf16_t*)(ws + WS_WUP), 2, 0, tile);
    transpose_job(P.in[21], DFF, 1024, (bf16_t*)(ws + WS_WDN), 0, 0, tile);
    __syncthreads();
}

__device__ void p2_token(const Params& P) {
    unsigned char* ws = P.ws; const int lane = threadIdx.x & 63; const int gw = blockIdx.x * 8 + (threadIdx.x >> 6), nw = gridDim.x * 8;
    const bf16_t* PROJ = (const bf16_t*)(ws + WS_PROJ); bf16_t* VN = (bf16_t*)(ws + WS_VN); bf16_t* CQN = (bf16_t*)(ws + WS_CQN);
    bf16_t* CK = (bf16_t*)(ws + WS_CKVN); bf16_t* KP = (bf16_t*)(ws + WS_KPE); const float* RT = (const float*)(ws + WS_ROPE);
    const float* lng = P.in[6]; const float* lnb = P.in[7]; const float* gq = P.in[10]; const float* gkv = P.in[12];
    float g8[8], b8[8];
#pragma unroll
    for (int e = 0; e < 8; ++e) { g8[e] = lng[lane * 8 + e]; b8[e] = lnb[lane * 8 + e]; }
    float gq6[6], gk4[4];
#pragma unroll
    for (int i = 0; i < 3; ++i) { gq6[2 * i] = gq[128 * i + 2 * lane]; gq6[2 * i + 1] = gq[128 * i + 2 * lane + 1]; }
#pragma unroll
    for (int e = 0; e < 4; ++e) gk4[e] = gkv[lane * 4 + e];
    const int kphys = rope_phys(lane);
    for (int t = gw; t < TOK; t += nw) {
        const bf16_t* pr = PROJ + (size_t)t * NIN;
        const int kvrow = t < TP ? t : TP + ((t - TP) >> 4) * KVS + 2048 + (t & 15);
        {
            const u32x4 w = *(const u32x4*)(pr + 512 + lane * 8);
            float x[8] = {blo(w.x), bhi(w.x), blo(w.y), bhi(w.y), blo(w.z), bhi(w.z), blo(w.w), bhi(w.w)};
            float s = 0.f;
#pragma unroll
            for (int e = 0; e < 8; ++e) s += x[e];
            const float mu = wsum(s) * (1.f / 512.f); float q = 0.f;
#pragma unroll
            for (int e = 0; e < 8; ++e) { x[e] -= mu; q += x[e] * x[e]; }
            const float rstd = rsqrtf(wsum(q) * (1.f / 512.f) + 1e-5f);
#pragma unroll
            for (int e = 0; e < 8; ++e) x[e] = x[e] * rstd * g8[e] + b8[e];
            u32x4 o; o.x = cvt_pk_bf16(x[0], x[1]); o.y = cvt_pk_bf16(x[2], x[3]); o.z = cvt_pk_bf16(x[4], x[5]); o.w = cvt_pk_bf16(x[6], x[7]);
            *(u32x4*)(VN + (size_t)t * 512 + lane * 8) = o;
            if (t >= TP) { float* go = P.out + O_GVS + (size_t)(t - TP) * 512 + lane * 8;
                *(f32x4*)go = (f32x4){x[0], x[1], x[2], x[3]}; *(f32x4*)(go + 4) = (f32x4){x[4], x[5], x[6], x[7]}; }
        }
        {
            float x[6]; float q = 0.f;
#pragma unroll
            for (int i = 0; i < 3; ++i) { const unsigned w = *(const unsigned*)(pr + 1024 + 128 * i + 2 * lane); x[2 * i] = blo(w); x[2 * i + 1] = bhi(w); q += x[2 * i] * x[2 * i] + x[2 * i + 1] * x[2 * i + 1]; }
            const float rstd = rsqrtf(wsum(q) * (1.f / 384.f) + 1e-6f);
#pragma unroll
            for (int i = 0; i < 3; ++i) *(unsigned*)(CQN + (size_t)t * 384 + 128 * i + 2 * lane) = cvt_pk_bf16(x[2 * i] * rstd * gq6[2 * i], x[2 * i + 1] * rstd * gq6[2 * i + 1]);
        }
        {
            const unsigned w0 = *(const unsigned*)(pr + 1408 + lane * 4), w1 = *(const unsigned*)(pr + 1408 + lane * 4 + 2);
            float x[4] = {blo(w0), bhi(w0), blo(w1), bhi(w1)};
            const float rstd = rsqrtf(wsum(x[0] * x[0] + x[1] * x[1] + x[2] * x[2] + x[3] * x[3]) * (1.f / 256.f) + 1e-6f);
#pragma unroll
            for (int e = 0; e < 4; ++e) x[e] = x[e] * rstd * gk4[e];
            float* co = P.out + (t < TP ? O_CKVP + (size_t)t * 256 : O_CKVS + (size_t)(t - TP) * 256) + lane * 4;
            *(f32x4*)co = (f32x4){x[0], x[1], x[2], x[3]};
            unsigned* ck = (unsigned*)(CK + (size_t)kvrow * 256 + lane * 4); ck[0] = cvt_pk_bf16(x[0], x[1]); ck[1] = cvt_pk_bf16(x[2], x[3]);
        }
        {
            const float x = bf2f(pr[1664 + lane]); const float other = __shfl_xor(x, 32); const int i = lane & 31, pos = tok_pos(t);
            const float c = RT[((size_t)pos * 32 + i) * 2], s = RT[((size_t)pos * 32 + i) * 2 + 1];
            const float o = lane < 32 ? x * c - other * s : x * c + other * s;
            P.out[(t < TP ? O_KPEP + (size_t)t * 64 : O_KPES + (size_t)(t - TP) * 64) + lane] = o;
            KP[(size_t)kvrow * 64 + kphys] = f2bf(o);
        }
    }
}

__device__ __forceinline__ int crow(int r, int hi) { return (r & 3) + 8 * (r >> 2) + 4 * hi; }
__device__ void spatial_phase(const Params& P, unsigned char* lds) {
    unsigned char* ws = P.ws; const int tid = threadIdx.x, wid = tid >> 6, lane = tid & 63, r32 = lane & 31, hi = lane >> 5;
    const bf16_t* PROJ = (const bf16_t*)(ws + WS_PROJ); const bf16_t* VN = (const bf16_t*)(ws + WS_VN); bf16_t* CAT = (bf16_t*)(ws + WS_CAT);
    bf16_t* VT = (bf16_t*)lds;
    const float* bs = P.in[9];
    for (int unit = blockIdx.x; unit < 513 * 4; unit += gridDim.x) {
        const int c = unit >> 2, h = unit & 3, tok0 = c * 128; const bool sample = (c == 512);
        const bf16_t* Wm = (const bf16_t*)(ws + (sample ? WS_WSS : WS_WSP)) + h * 16384;
        __syncthreads();
        {   const int j = tid >> 2, dq = (tid & 3) * 32; const bf16_t* src = VN + (size_t)(tok0 + j) * 512 + h * 128 + dq;
#pragma unroll
            for (int i = 0; i < 4; ++i) { const u32x4 w = *(const u32x4*)(src + 8 * i); const unsigned ww[4] = {w.x, w.y, w.z, w.w};
#pragma unroll
                for (int e = 0; e < 4; ++e) { VT[(dq + 8 * i + 2 * e) * 136 + j] = (bf16_t)(ww[e] & 0xffffu); VT[(dq + 8 * i + 2 * e + 1) * 136 + j] = (bf16_t)(ww[e] >> 16); } }
        }
        __syncthreads();
        const int ib = wid >> 1, db0 = (wid & 1) * 2;
        f32x16 a0 = {}, a1 = {};
#pragma unroll
        for (int k = 0; k < 8; ++k) {
            const bf16x8 a = *(const bf16x8*)(Wm + (ib * 32 + r32) * 128 + k * 16 + hi * 8);
            const bf16x8 b0 = *(const bf16x8*)(VT + (db0 * 32 + r32) * 136 + k * 16 + hi * 8);
            const bf16x8 b1 = *(const bf16x8*)(VT + ((db0 + 1) * 32 + r32) * 136 + k * 16 + hi * 8);
            a0 = __builtin_amdgcn_mfma_f32_32x32x16_bf16(a, b0, a0, 0, 0, 0);
            a1 = __builtin_amdgcn_mfma_f32_32x32x16_bf16(a, b1, a1, 0, 0, 0);
        }
#pragma unroll
        for (int r = 0; r < 16; ++r) { const int i = ib * 32 + crow(r, hi), tok = tok0 + i; const float bias = bs[h * 128 + (sample ? (i & 15) : i)];
            const int d0 = h * 128 + db0 * 32 + r32;
            const float u0 = bf2f(PROJ[(size_t)tok * NIN + d0]), u1 = bf2f(PROJ[(size_t)tok * NIN + d0 + 32]);
            CAT[(size_t)tok * 1024 + d0] = f2bf(u0 * (a0[r] + bias)); CAT[(size_t)tok * 1024 + d0 + 32] = f2bf(u1 * (a1[r] + bias)); }
    }
    __syncthreads();
}

namespace att {
constexpr int SHM_V = 16384, SHM_K = 16384, SHM_P = 8192;
constexpr int OFF_V = 0, OFF_K = 2 * SHM_V, OFF_P = OFF_K + 2 * SHM_K, OFF_WS = OFF_P + 2 * SHM_P;
#define KSWZ(row, colB) ((row) * 256 + ((colB) ^ (((row) & 7) << 4)))
#define PSWZ(row, colB) ((row) * 128 + ((colB) ^ (((row) & 7) << 4)))
#define SBAR() __builtin_amdgcn_sched_barrier(0)
__device__ __forceinline__ int v_st(int k, int c) { const int kk = (k & ~0xC) | ((k & 4) << 1) | ((k & 8) >> 1); return ((kk >> 3) * 4 + (c >> 5)) * 512 + ((kk & 7) * 32 + (c & 31)) * 2; }
__device__ __forceinline__ int v_rd_base(int lane) { return ((lane & 3) << 3) | (((lane >> 2) & 3) << 6) | (((lane >> 4) & 1) << 5) | (((lane >> 5) & 1) << 8); }
constexpr int v_rd_off(int d0, int ks, int half) { return d0 * 512 + ks * 4096 + half * 2048; }
template <int OFF> __device__ __forceinline__ s16x4 tr_read(int vb) {
    s16x4 r; asm volatile("ds_read_b64_tr_b16 %0, %1 offset:%2" : "=&v"(r) : "v"(vb), "i"(OFF) : "memory"); return r; }
template <int D0> __device__ __forceinline__ void pv_one(f32x16& od, int vb, bf16x8 pa0, bf16x8 pa1, bf16x8 pa2, bf16x8 pa3) {
    const s16x4 l0 = tr_read<v_rd_off(D0, 0, 0)>(vb), h0 = tr_read<v_rd_off(D0, 0, 1)>(vb), l1 = tr_read<v_rd_off(D0, 1, 0)>(vb), h1 = tr_read<v_rd_off(D0, 1, 1)>(vb);
    const s16x4 l2 = tr_read<v_rd_off(D0, 2, 0)>(vb), h2 = tr_read<v_rd_off(D0, 2, 1)>(vb), l3 = tr_read<v_rd_off(D0, 3, 0)>(vb), h3 = tr_read<v_rd_off(D0, 3, 1)>(vb);
    asm volatile("s_waitcnt lgkmcnt(0)" ::: "memory"); SBAR();
#define PK(L, H) (bf16x8){L[0], L[1], L[2], L[3], H[0], H[1], H[2], H[3]}
    od = __builtin_amdgcn_mfma_f32_32x32x16_bf16(pa0, PK(l0, h0), od, 0, 0, 0);
    od = __builtin_amdgcn_mfma_f32_32x32x16_bf16(pa1, PK(l1, h1), od, 0, 0, 0);
    od = __builtin_amdgcn_mfma_f32_32x32x16_bf16(pa2, PK(l2, h2), od, 0, 0, 0);
    od = __builtin_amdgcn_mfma_f32_32x32x16_bf16(pa3, PK(l3, h3), od, 0, 0, 0);
#undef PK
}
__device__ __forceinline__ void attn_unit(const bf16_t* __restrict__ Qrow  , const float* __restrict__ ropeRow  ,
                                          const bf16_t* __restrict__ KVh  ,
                                          const bf16_t* __restrict__ KPh  , bf16_t* __restrict__ Orow0  ,
                                          int orows  , int NT, int nact, int kvalid, unsigned char* lds) {
    const int tid = threadIdx.x, wid = __builtin_amdgcn_readfirstlane(tid >> 6), lane = tid & 63, r32 = lane & 31, hi = lane >> 5;
    unsigned char* V_lds = lds + OFF_V; unsigned char* K_lds = lds + OFF_K; unsigned char* P_lds = lds + OFF_P;
    float* wsf = (float*)(lds + OFF_WS) + wid * 64; float* li_l = wsf; float* al_l = wsf + 32;
    float m_reg = -1e30f, l_reg = 0.f; f32x16 o[4] = {}; bf16x8 qr[12];
#pragma unroll
    for (int d0 = 0; d0 < 12; ++d0) qr[d0] = *(const bf16x8*)(Qrow + hi * 8 + d0 * 16);
#pragma unroll
    for (int d0 = 0; d0 < 4; ++d0) {
        const int i0 = (d0 >> 1) * 16 + ((d0 & 1) * 2 + hi) * 4; const float* rp = ropeRow + i0 * 2;
        const f32x4 c01 = *(const f32x4*)rp, c23 = *(const f32x4*)(rp + 4);
        const float cs[4] = {c01[0], c01[2], c23[0], c23[2]}, sn[4] = {c01[1], c01[3], c23[1], c23[3]};
        const u32x4 w = *reinterpret_cast<const u32x4*>(&qr[8 + d0]);
        const float x1[4] = {blo(w.x), bhi(w.x), blo(w.y), bhi(w.y)}, x2[4] = {blo(w.z), bhi(w.z), blo(w.w), bhi(w.w)};
        float y1[4], y2[4];
#pragma unroll
        for (int e = 0; e < 4; ++e) { y1[e] = x1[e] * cs[e] - x2[e] * sn[e]; y2[e] = x2[e] * cs[e] + x1[e] * sn[e]; }
        u32x4 ow; ow.x = cvt_pk_bf16(y1[0], y1[1]); ow.y = cvt_pk_bf16(y1[2], y1[3]); ow.z = cvt_pk_bf16(y2[0], y2[1]); ow.w = cvt_pk_bf16(y2[2], y2[3]);
        qr[8 + d0] = *reinterpret_cast<bf16x8*>(&ow);
    }
    int kofs[2], vofs[2], pofs;
#pragma unroll
    for (int i = 0; i < 2; ++i) { const int c = wid + 8 * i;
        { const int row = 4 * c + (lane >> 4), colB = ((lane & 15) * 16) ^ ((row & 7) << 4); kofs[i] = row * 1024 + (colB >> 1); }
        { const int st = 2 * c + (lane >> 5), kk = (st >> 2) * 8 + ((lane & 31) >> 2), col = (st & 3) * 32 + (lane & 3) * 8;
          const int k = (kk & ~0xC) | ((kk & 4) << 1) | ((kk & 8) >> 1); vofs[i] = k * 1024 + 512 + col; } }
    { const int row = wid * 8 + (lane >> 3), colB = ((lane & 7) * 16) ^ ((row & 7) << 4); pofs = row * 64 + (colB >> 1); }
    const int vb0 = (int)(uintptr_t)(V_lds) + v_rd_base(lane);
#define GLDS(gp, lp) __builtin_amdgcn_global_load_lds((const unsigned*)(gp), (PG8_LAS unsigned*)(lp), 16, 0, 0)
#define STAGE_T(k0, b) do { const bf16_t* kb_ = KVh + (size_t)(k0) * 1024; \
        GLDS(kb_ + kofs[0], K_lds + (b) * SHM_K + wid * 1024); GLDS(kb_ + kofs[1], K_lds + (b) * SHM_K + (wid + 8) * 1024); \
        GLDS(kb_ + vofs[0], V_lds + (b) * SHM_V + wid * 1024); GLDS(kb_ + vofs[1], V_lds + (b) * SHM_V + (wid + 8) * 1024); \
        GLDS(KPh + (size_t)(k0) * 64 + pofs, P_lds + (b) * SHM_P + wid * 1024); } while (0)
    STAGE_T(0, 0); asm volatile("s_waitcnt vmcnt(0)" ::: "memory"); __syncthreads();
    for (int j = 0; j < NT; ++j) {
        const int buf = j & 1; const bool more = (j + 1 < NT);
        if (more) STAGE_T((j + 1) * 64, buf ^ 1);
        if (j < nact) {
            const unsigned char* Ks = K_lds + buf * SHM_K; const unsigned char* Ps = P_lds + buf * SHM_P;
            f32x16 p0 = {}, p1 = {};
#pragma unroll
            for (int d0 = 0; d0 < 8; ++d0) { const int cb = (d0 * 16 + hi * 8) * 2;
                const bf16x8 b0 = *(const bf16x8*)(Ks + KSWZ(r32, cb)), b1 = *(const bf16x8*)(Ks + KSWZ(32 + r32, cb));
                p0 = __builtin_amdgcn_mfma_f32_32x32x16_bf16(b0, qr[d0], p0, 0, 0, 0); p1 = __builtin_amdgcn_mfma_f32_32x32x16_bf16(b1, qr[d0], p1, 0, 0, 0); }
#pragma unroll
            for (int d0 = 0; d0 < 4; ++d0) { const int cb = (d0 * 16 + hi * 8) * 2;
                const bf16x8 b0 = *(const bf16x8*)(Ps + PSWZ(r32, cb)), b1 = *(const bf16x8*)(Ps + PSWZ(32 + r32, cb));
                p0 = __builtin_amdgcn_mfma_f32_32x32x16_bf16(b0, qr[8 + d0], p0, 0, 0, 0); p1 = __builtin_amdgcn_mfma_f32_32x32x16_bf16(b1, qr[8 + d0], p1, 0, 0, 0); }
            if (j == NT - 1 && kvalid < 64) {
#pragma unroll
                for (int r = 0; r < 16; ++r) { if (crow(r, hi) >= kvalid) p0[r] = -1e30f; if (32 + crow(r, hi) >= kvalid) p1[r] = -1e30f; } }
            float pmax = p0[0];
#pragma unroll
            for (int r = 1; r < 16; ++r) pmax = fmaxf(pmax, p0[r]);
#pragma unroll
            for (int r = 0; r < 16; ++r) pmax = fmaxf(pmax, p1[r]);
            { auto rr = __builtin_amdgcn_permlane32_swap(__float_as_uint(pmax), __float_as_uint(pmax), false, false); pmax = fmaxf(__uint_as_float(rr[0]), __uint_as_float(rr[1])); }
            const float mn = fmaxf(m_reg, pmax); const float alpha = __builtin_amdgcn_exp2f(m_reg - mn); m_reg = mn;
            float ps = 0.f;
#pragma unroll
            for (int r = 0; r < 16; ++r) { p0[r] = __builtin_amdgcn_exp2f(p0[r] - mn); p1[r] = __builtin_amdgcn_exp2f(p1[r] - mn); ps += p0[r] + p1[r]; }
            { auto rr = __builtin_amdgcn_permlane32_swap(__float_as_uint(ps), __float_as_uint(ps), false, false); ps = __uint_as_float(rr[0]) + __uint_as_float(rr[1]); }
            l_reg = l_reg * alpha + ps;
            bf16x8 pa0, pa1, pa2, pa3;
#define PK4(Pv, BASE, OUT) do { unsigned a0 = cvt_pk_bf16(Pv[BASE + 0], Pv[BASE + 1]), a1 = cvt_pk_bf16(Pv[BASE + 2], Pv[BASE + 3]); \
        unsigned b0_ = cvt_pk_bf16(Pv[BASE + 4], Pv[BASE + 5]), b1_ = cvt_pk_bf16(Pv[BASE + 6], Pv[BASE + 7]); \
        auto r0 = __builtin_amdgcn_permlane32_swap(a0, b0_, false, false); auto r1 = __builtin_amdgcn_permlane32_swap(a1, b1_, false, false); \
        u32x4 w_ = {r0[0], r1[0], r0[1], r1[1]}; OUT = *reinterpret_cast<bf16x8*>(&w_); } while (0)
            PK4(p0, 0, pa0); PK4(p0, 8, pa1); PK4(p1, 0, pa2); PK4(p1, 8, pa3);
#undef PK4
            if (__any(alpha < 1.f)) { if (hi == 0) al_l[r32] = alpha; asm volatile("s_waitcnt lgkmcnt(0)" ::: "memory");
#pragma unroll
                for (int r = 0; r < 16; ++r) { const float a = al_l[crow(r, hi)];
#pragma unroll
                    for (int d = 0; d < 4; ++d) o[d][r] *= a; } }
            const int vb = vb0 + buf * SHM_V;
            pv_one<0>(o[0], vb, pa0, pa1, pa2, pa3); pv_one<1>(o[1], vb, pa0, pa1, pa2, pa3); pv_one<2>(o[2], vb, pa0, pa1, pa2, pa3); pv_one<3>(o[3], vb, pa0, pa1, pa2, pa3);
        }
        asm volatile("s_waitcnt vmcnt(0)" ::: "memory");
        __syncthreads();
    }
#undef STAGE_T
#undef GLDS
    if (nact > 0) {
        if (hi == 0) li_l[r32] = l_reg; asm volatile("s_waitcnt lgkmcnt(0)" ::: "memory");
#pragma unroll
        for (int r = 0; r < 16; ++r) { const int orow = crow(r, hi); if (orow < orows) { const float rl = __builtin_amdgcn_rcpf(li_l[orow]);
#pragma unroll
            for (int d0 = 0; d0 < 4; ++d0) Orow0[(size_t)orow * 1024 + d0 * 32 + r32] = f2bf(o[d0][r] * rl); } }
    }
}
__device__ void attn_phase(const Params& P, unsigned char* lds) {
    unsigned char* ws = P.ws; const int tid = threadIdx.x, wid = tid >> 6, lane = tid & 63, r32 = lane & 31;
    const bf16_t* QB = (const bf16_t*)(ws + WS_QB); const bf16_t* KVB = (const bf16_t*)(ws + WS_KVB); const bf16_t* KPE = (const bf16_t*)(ws + WS_KPE); bf16_t* CAT = (bf16_t*)(ws + WS_CAT); const float* RT = (const float*)(ws + WS_ROPE);
    for (int pr = blockIdx.x; pr < 512; pr += gridDim.x) {
        const int c = pr & 255, rnd = pr >> 8, xcd = c & 7, slot = c >> 3, bh = rnd * 16 + xcd * 2 + (slot >> 4), x = slot & 15, b = bh >> 2, h = bh & 3;
#pragma unroll 1
        for (int s = 0; s < 2; ++s) { const int qb = s == 0 ? 31 - x : x; const int q0 = b * 8192 + qb * 256 + wid * 32;
            attn_unit(QB + (size_t)(q0 + r32) * 768 + h * 192, RT + (size_t)((q0 + r32) & 8191) * 64, KVB + (size_t)(b * 8192) * 1024 + h * 128, KPE + (size_t)(b * 8192) * 64,
                      CAT + (size_t)q0 * 1024 + 512 + h * 128, 32, 4 * qb + 4, 4 * qb + 1 + (wid >> 1), 64, lds); }
    }
    for (int su = blockIdx.x; su < 32; su += gridDim.x) { const int b = su >> 2, h = su & 3; const int q0 = TP + b * 16;
        attn_unit(QB + (size_t)(q0 + (r32 & 15)) * 768 + h * 192, RT + (size_t)(2048 + (r32 & 15)) * 64, KVB + (size_t)(TP + b * KVS) * 1024 + h * 128, KPE + (size_t)(TP + b * KVS) * 64,
                  CAT + (size_t)q0 * 1024 + 512 + h * 128, 16, 33, wid == 0 ? 33 : 0, 16, lds); }
}
}

__device__ void ln1_phase(const Params& P) {
    unsigned char* ws = P.ws; const int lane = threadIdx.x & 63; const int gw = blockIdx.x * 8 + (threadIdx.x >> 6), nw = gridDim.x * 8;
    const bf16_t* R1 = (const bf16_t*)(ws + WS_R1); bf16_t* H = (bf16_t*)(ws + WS_H); const float* g = P.in[16]; const float* bb = P.in[17];
    float gg[16], bv[16];
#pragma unroll
    for (int e = 0; e < 8; ++e) { gg[e] = g[lane * 8 + e]; gg[8 + e] = g[512 + lane * 8 + e]; bv[e] = bb[lane * 8 + e]; bv[8 + e] = bb[512 + lane * 8 + e]; }
    for (int t = gw; t < TOK; t += nw) {
        const u32x4 w0 = *(const u32x4*)(R1 + (size_t)t * 1024 + lane * 8), w1 = *(const u32x4*)(R1 + (size_t)t * 1024 + 512 + lane * 8);
        float x[16] = {blo(w0.x), bhi(w0.x), blo(w0.y), bhi(w0.y), blo(w0.z), bhi(w0.z), blo(w0.w), bhi(w0.w), blo(w1.x), bhi(w1.x), blo(w1.y), bhi(w1.y), blo(w1.z), bhi(w1.z), blo(w1.w), bhi(w1.w)};
        float s = 0.f;
#pragma unroll
        for (int e = 0; e < 16; ++e) s += x[e];
        const float mu = wsum(s) * (1.f / 1024.f); float q = 0.f;
#pragma unroll
        for (int e = 0; e < 16; ++e) { x[e] -= mu; q += x[e] * x[e]; }
        const float rstd = rsqrtf(wsum(q) * (1.f / 1024.f) + 1e-5f);
#pragma unroll
        for (int e = 0; e < 16; ++e) x[e] = x[e] * rstd * gg[e] + bv[e];
        u32x4 o0, o1; o0.x = cvt_pk_bf16(x[0], x[1]); o0.y = cvt_pk_bf16(x[2], x[3]); o0.z = cvt_pk_bf16(x[4], x[5]); o0.w = cvt_pk_bf16(x[6], x[7]);
        o1.x = cvt_pk_bf16(x[8], x[9]); o1.y = cvt_pk_bf16(x[10], x[11]); o1.z = cvt_pk_bf16(x[12], x[13]); o1.w = cvt_pk_bf16(x[14], x[15]);
        *(u32x4*)(H + (size_t)t * 1024 + lane * 8) = o0; *(u32x4*)(H + (size_t)t * 1024 + 512 + lane * 8) = o1;
    }
}
__device__ void ln2_phase(const Params& P) {
    const int lane = threadIdx.x & 63; const int gw = blockIdx.x * 8 + (threadIdx.x >> 6), nw = gridDim.x * 8;
    float* Y = P.out + O_YP; const float* g = P.in[22]; const float* bb = P.in[23];
    f32x4 gg[4], bv[4];
#pragma unroll
    for (int i = 0; i < 4; ++i) { gg[i] = *(const f32x4*)(g + i * 256 + lane * 4); bv[i] = *(const f32x4*)(bb + i * 256 + lane * 4); }
    for (int t = gw; t < TOK; t += nw) {
        float* yr = Y + (size_t)t * 1024; f32x4 x[4]; float s = 0.f;
#pragma unroll
        for (int i = 0; i < 4; ++i) { x[i] = *(const f32x4*)(yr + i * 256 + lane * 4); s += (x[i][0] + x[i][1]) + (x[i][2] + x[i][3]); }
        const float mu = wsum(s) * (1.f / 1024.f); float q = 0.f;
#pragma unroll
        for (int i = 0; i < 4; ++i) { x[i] = x[i] - mu; q += (x[i][0] * x[i][0] + x[i][1] * x[i][1]) + (x[i][2] * x[i][2] + x[i][3] * x[i][3]); }
        const float rstd = rsqrtf(wsum(q) * (1.f / 1024.f) + 1e-5f);
#pragma unroll
        for (int i = 0; i < 4; ++i) *(f32x4*)(yr + i * 256 + lane * 4) = x[i] * rstd * gg[i] + bv[i];
    }
}
__device__ __forceinline__ void ld8bf(const bf16_t* p, float* x) { const u32x4 w = *(const u32x4*)p; x[0] = blo(w.x); x[1] = bhi(w.x); x[2] = blo(w.y); x[3] = bhi(w.y); x[4] = blo(w.z); x[5] = bhi(w.z); x[6] = blo(w.w); x[7] = bhi(w.w); }
__device__ __forceinline__ void ld8f(const float* p, float* x) { const f32x4 a = *(const f32x4*)p, b = *(const f32x4*)(p + 4); x[0] = a[0]; x[1] = a[1]; x[2] = a[2]; x[3] = a[3]; x[4] = b[0]; x[5] = b[1]; x[6] = b[2]; x[7] = b[3]; }
__device__ void ffn_fix_phase(const Params& P) {
    unsigned char* ws = P.ws; const long gtid = blockIdx.x * 512L + threadIdx.x, gsz = gridDim.x * 512L;
    const bf16_t* BND = (const bf16_t*)(ws + WS_BND); const bf16_t* UPS = (const bf16_t*)(ws + WS_UPS); bf16_t* ACT = (bf16_t*)(ws + WS_ACT);
    const float* wc = P.in[19]; const float* bc = P.in[20]; const float* st = P.in[4];
    const long n_p = 1024L * 2 * 352, n_s = 128L * 352;
    for (long it = gtid; it < n_p + n_s; it += gsz) {
        const bool samp = it >= n_p; const long q = samp ? it - n_p : it;
        const int f = (int)(q % 352) * 8; const int rr = (int)(q / 352);
        int t; float res[2][8];
#pragma unroll
        for (int part = 0; part < 2; ++part) { const int col = f + part * DFF; float x2[8], x1[8], x0[8];
            if (!samp) { const int s_ = rr >> 1, r = rr & 1; t = s_ * 64 + r; const bool first = (s_ & 127) == 0;
                const bf16_t* B = BND + (size_t)s_ * 4 * DFF2 + col;
                ld8bf(B + (size_t)r * DFF2, x2);
                if (r == 1) ld8bf(B, x1); else if (!first) ld8bf(B - (size_t)1 * DFF2, x1); else {
#pragma unroll
                    for (int e = 0; e < 8; ++e) x1[e] = 0.f; }
                if (!first) ld8bf(B - (size_t)(r == 1 ? 1 : 2) * DFF2, x0); else {
#pragma unroll
                    for (int e = 0; e < 8; ++e) x0[e] = 0.f; }
            } else { const int pos = rr & 15, sb = rr >> 4; t = TP + rr;
                ld8bf(UPS + (size_t)rr * DFF2 + col, x2);
                if (pos >= 1) ld8bf(UPS + (size_t)(rr - 1) * DFF2 + col, x1); else ld8f(st + ((size_t)sb * 2 + 1) * DFF2 + col, x1);
                if (pos >= 2) ld8bf(UPS + (size_t)(rr - 2) * DFF2 + col, x0); else ld8f(st + ((size_t)sb * 2 + pos) * DFF2 + col, x0);
            }
            float w2[8], w1[8], w0[8], bb[8]; ld8f(wc + 2 * DFF2 + col, w2); ld8f(wc + DFF2 + col, w1); ld8f(wc + col, w0); ld8f(bc + col, bb);
#pragma unroll
            for (int e = 0; e < 8; ++e) res[part][e] = bb[e] + w2[e] * x2[e] + w1[e] * x1[e] + w0[e] * x0[e];
        }
        u32x4 o;
        o.x = cvt_pk_bf16(silu(res[0][0]) * res[1][0], silu(res[0][1]) * res[1][1]); o.y = cvt_pk_bf16(silu(res[0][2]) * res[1][2], silu(res[0][3]) * res[1][3]);
        o.z = cvt_pk_bf16(silu(res[0][4]) * res[1][4], silu(res[0][5]) * res[1][5]); o.w = cvt_pk_bf16(silu(res[0][6]) * res[1][6], silu(res[0][7]) * res[1][7]);
        *(u32x4*)(ACT + (size_t)t * DFF + f) = o;
    }
    for (long it = gtid; it < 2L * 16 * DFF2; it += gsz) { const int col = (int)(it % DFF2); const int rj = (int)(it / DFF2); const bool samp = rj >= 16; const int b = (rj & 15) >> 1, j = rj & 1;
        if (!samp) P.out[O_FCP + ((size_t)b * 2 + j) * DFF2 + col] = bf2f(BND[((size_t)(b * 128 + 127) * 4 + 2 + j) * DFF2 + col]);
        else P.out[O_FCS + ((size_t)b * 2 + j) * DFF2 + col] = bf2f(UPS[(size_t)(b * 16 + 14 + j) * DFF2 + col]); }
}

constexpr int NPHASE = 11;
__global__ void __launch_bounds__(512, 2) mega_fwd(Params P) {
    extern __shared__ __attribute__((aligned(16))) unsigned char lds[];
    cg::grid_group grid = cg::this_grid();
    PG8_LAS unsigned char* ldsl = (PG8_LAS unsigned char*)lds;
    unsigned char* ws = P.ws; const int lo = P.ph_lo, hi = P.ph_hi; const int G = gridDim.x, bx = blockIdx.x;
#ifndef PHMASK
#define PHMASK 0xFFFF
#endif
#define IN(k) (((PHMASK >> (k)) & 1) && lo <= (k) && (k) < hi)
#define SEAM(k) do { if (IN(k) && IN((k) + 1)) grid.sync(); } while (0)
    if (IN(0)) p0_prologue(P, lds);
    SEAM(0);
    if (IN(1)) { pg8::Gemm g{(const bf16_t*)(ws + WS_XB), (const bf16_t*)(ws + WS_WIN), TOKP, NIN, 1024}; pg8::StaticOrder S; S.init(TOKP, NIN, G, bx);
        pg8::EpiPlain E{(bf16_t*)(ws + WS_PROJ), NIN, 4, 1.f}; pg8::gemm_phase<pg8::EpiPlain, pg8::StaticOrder, true, true>(ldsl, g, S, E); }
    SEAM(1);
    if (IN(2)) p2_token(P);
    SEAM(2);
    if (IN(3)) {
#ifndef NOQ
        { pg8::Gemm g{(const bf16_t*)(ws + WS_CQN), (const bf16_t*)(ws + WS_WUQ), TOKP, 768, 384}; pg8::StaticOrder S; S.init(TOKP, 768, G, bx);
          pg8::EpiPlain E{(bf16_t*)(ws + WS_QB), 768, 0, QSCALE}; pg8::gemm_phase<pg8::EpiPlain, pg8::StaticOrder, true, true>(ldsl, g, S, E); }
#endif
#ifndef NOKV
        { pg8::Gemm g{(const bf16_t*)(ws + WS_CKVN), (const bf16_t*)(ws + WS_WKV), KVRP, 1024, 256}; pg8::StaticOrder S; S.init(KVRP, 1024, G, bx);
          pg8::EpiPlain E{(bf16_t*)(ws + WS_KVB), 1024, 0, 1.f}; pg8::gemm_phase<pg8::EpiPlain, pg8::StaticOrder, true, true>(ldsl, g, S, E); }
#endif
#ifndef NOSP
        spatial_phase(P, lds);
#endif
    }
    SEAM(3);
    if (IN(4)) att::attn_phase(P, lds);
    SEAM(4);
    if (IN(5)) { pg8::Gemm g{(const bf16_t*)(ws + WS_CAT), (const bf16_t*)(ws + WS_WO), TOKP, 1024, 1024}; pg8::StaticOrder S; S.init(TOKP, 1024, G, bx);
        pg8::EpiWo E{(bf16_t*)(ws + WS_R1), P.in[0], P.in[1]}; pg8::gemm_phase<pg8::EpiWo, pg8::StaticOrder, true, true>(ldsl, g, S, E); }
    SEAM(5);
    if (IN(6)) ln1_phase(P);
    SEAM(6);
    if (IN(7)) { pg8::Gemm g{(const bf16_t*)(ws + WS_H), (const bf16_t*)(ws + WS_WUP), TOKP, DFF2, 1024}; pg8::StaticOrder S; S.init(TOKP, DFF2, G, bx);
        pg8::EpiUpConv E{(bf16_t*)(ws + WS_ACT), (bf16_t*)(ws + WS_BND), (bf16_t*)(ws + WS_UPS), P.in[19], P.in[20]}; pg8::gemm_phase<pg8::EpiUpConv, pg8::StaticOrder, true, true>(ldsl, g, S, E); }
    SEAM(7);
    if (IN(8)) ffn_fix_phase(P);
    SEAM(8);
    if (IN(9)) { pg8::Gemm g{(const bf16_t*)(ws + WS_ACT), (const bf16_t*)(ws + WS_WDN), TOKP, 1024, DFF}; pg8::StaticOrder S; S.init(TOKP, 1024, G, bx);
        pg8::EpiDown E{P.out + O_YP, (const bf16_t*)(ws + WS_H)}; pg8::gemm_phase<pg8::EpiDown, pg8::StaticOrder, true, true>(ldsl, g, S, E); }
    SEAM(9);
    if (IN(10)) ln2_phase(P);
#undef IN
#undef SEAM
}

extern "C" void kernel_launch(void* const* d_in, const int* in_sizes, int n_in, void* d_out, int out_size, void* d_ws, size_t ws_size, hipStream_t stream) {
    static int grid_blocks = 0;
    if (grid_blocks == 0) {
        if (n_in != 24 || out_size != (int)O_END || ws_size < WS_END) { fprintf(stderr, "kernel_launch: unexpected shapes: n_in %d out %d ws %zu (need %zu)\n", n_in, out_size, ws_size, (size_t)WS_END); grid_blocks = -1; return; }
        int dev = 0, cus = 0, per_cu = 0;
        hipGetDevice(&dev); hipDeviceGetAttribute(&cus, hipDeviceAttributeMultiprocessorCount, dev);
        if (hipFuncSetAttribute((const void*)mega_fwd, hipFuncAttributeMaxDynamicSharedMemorySize, LDS_BYTES) != hipSuccess) { fprintf(stderr, "kernel_launch: hipFuncSetAttribute failed\n"); grid_blocks = -1; return; }
        if (hipOccupancyMaxActiveBlocksPerMultiprocessor(&per_cu, (const void*)mega_fwd, 512, LDS_BYTES) != hipSuccess || per_cu < 1) { fprintf(stderr, "kernel_launch: occupancy query gave %d\n", per_cu); per_cu = 1; }
        (void)hipGetLastError();
        grid_blocks = cus * 1;
    }
    if (grid_blocks < 0) return;
    Params p{};
    for (int i = 0; i < 24; ++i) p.in[i] = (const float*)d_in[i];
    p.out = (float*)d_out; p.ws = (unsigned char*)d_ws;
#if defined(MK_MULTI)
    for (int ph = 0; ph < NPHASE; ++ph) { p.ph_lo = ph; p.ph_hi = ph + 1; hipLaunchKernelGGL(mega_fwd, dim3(grid_blocks), dim3(512), LDS_BYTES, stream, p); }
#else
    p.ph_lo = 0; p.ph_hi = NPHASE;
    void* args[] = {&p};
    hipError_t e = hipLaunchCooperativeKernel((const void*)mega_fwd, dim3(grid_blocks), dim3(512), args, LDS_BYTES, stream);
    if (e != hipSuccess) fprintf(stderr, "kernel_launch: cooperative launch failed: %s (grid %d)\n", hipGetErrorString(e), grid_blocks);
#endif
}
```

```cpp
#include <hip/hip_runtime.h>
#include <hip/hip_cooperative_groups.h>
#include <cstdio>
#include <cstdint>
namespace cg = cooperative_groups;
namespace pg8 {
#define PG8_LAS __attribute__((address_space(3)))
typedef unsigned short bf16_t;
typedef short bf16x8 __attribute__((ext_vector_type(8)));
typedef float f32x4 __attribute__((ext_vector_type(4)));
typedef unsigned u32x4 __attribute__((ext_vector_type(4)));
constexpr int BM = 256, BK = 64, HALF = 128, HTB = HALF * BK * 2  , STAGE_BYTES = 8 * HTB, NXCD = 8, WGM = 8;

__host__ __device__ __forceinline__ int lds_byte(int r, int c) { const int st = (r >> 4) * 2 + (c >> 5), rr = r & 15, cc = c & 31, ob = rr * 64 + cc * 2; return st * 1024 + (ob ^ (((ob >> 9) & 1) << 5)); }
__host__ __device__ __forceinline__ void stage_rc(int b, int& R, int& C) { const int st = b / 1024, sb = b % 1024, swz = sb ^ (((sb >> 9) & 1) << 5); R = (st >> 1) * 16 + swz / 64; C = (st & 1) * 32 + (swz % 64) / 2; }
__host__ __device__ __forceinline__ int perm32(int rho) { const int n = rho >> 4, i = rho & 15; return 8 * (i >> 2) + 4 * n + (i & 3); }

struct Unit { int pm, pn; };
struct Gemm { const bf16_t* A; const bf16_t* Bt; int M, N, K; };

struct StaticOrder {
    int nM, nN, nwg, G, c;
    __host__ __device__ void init(int M, int N, int G_, int c_) { nM = M / BM; nN = N / BM; nwg = nM * nN; G = G_; c = c_; }
    __host__ __device__ bool next(int i, Unit& u) const {
        const long L = (long)i * G + c; if (L >= nwg) return false;
        int wgid = (int)L; { const int q = nwg / NXCD, r = nwg % NXCD, xcd = wgid % NXCD, off = wgid / NXCD; wgid = (xcd < r ? xcd * (q + 1) : r * (q + 1) + (xcd - r) * q) + off; }
        const int nig = WGM * nN, gid = wgid / nig, fm = gid * WGM, gsz = (nM - fm) < WGM ? (nM - fm) : WGM;
        u.pm = fm + ((wgid % nig) % gsz); u.pn = (wgid % nig) / gsz; return true;
    }
    __device__ __forceinline__ void a_ready(const Unit&) const {}
    __device__ __forceinline__ void done(const Unit&) const {}
};

__device__ __forceinline__ unsigned cvt_pk_bf16(float lo, float hi) { unsigned r; asm volatile("v_cvt_pk_bf16_f32 %0, %1, %2" : "=v"(r) : "v"(lo), "v"(hi)); return r; }
typedef float f32x2 __attribute__((ext_vector_type(2)));
template <class Epi, class Sched, bool ALIGN_EPI = false, bool SP2 = false>
__device__ __forceinline__ void gemm_phase(PG8_LAS unsigned char* lds, const Gemm g, const Sched& S, const Epi& E) {
    const int tid = threadIdx.x, wid = __builtin_amdgcn_readfirstlane(tid >> 6), lane = tid & 63, wr = wid >> 2, wc = wid & 3, fr = lane & 15, fq = lane >> 4;
    const int K = g.K, nt = K / BK;
    unsigned voffA[2], voffB[2];
#pragma unroll
    for (int i = 0; i < 2; ++i) { int R, C; stage_rc(tid * 16 + i * 8192, R, C); const int Rb = Epi::PERM ? ((R & ~31) + perm32(R & 31)) : R;
        voffA[i] = (unsigned)(R * K + C) * 2u; voffB[i] = (unsigned)(Rb * K + C) * 2u; }
    const size_t kstep = (size_t)(BK * 2);
    const size_t hstep = (size_t)HALF * K * 2;
    const size_t tstep = 2 * hstep;
    const unsigned ldsw = (unsigned)wid * 1024u;
    const int aoff = lds_byte(wr * 64 + fr, fq * 8), boff = lds_byte(wc * 32 + fr, fq * 8);
#define PG8_SA(b, h) (((b) * 2 + (h)) * HTB)
#define PG8_SB(b, h) ((4 + (b) * 2 + (h)) * HTB)
#define PG8_STAGE(bufoff, gbase, voff) do { _Pragma("unroll") for (int _i = 0; _i < 2; ++_i) \
        __builtin_amdgcn_global_load_lds((const unsigned*)((const char*)(gbase) + (voff)[_i]), (PG8_LAS unsigned*)(lds + (bufoff) + ldsw + _i * 8192), 16, 0, 0); } while (0)
#define PG8_LDA(dst, b, h) do { _Pragma("unroll") for (int m = 0; m < 4; ++m) _Pragma("unroll") for (int k = 0; k < 2; ++k) dst[m][k] = *(const PG8_LAS bf16x8*)(lds + PG8_SA(b, h) + aoff + m * 2048 + k * 1024); } while (0)
#define PG8_LDB(dst, b, h) do { _Pragma("unroll") for (int n = 0; n < 2; ++n) _Pragma("unroll") for (int k = 0; k < 2; ++k) dst[n][k] = *(const PG8_LAS bf16x8*)(lds + PG8_SB(b, h) + boff + n * 2048 + k * 1024); } while (0)
#define PG8_MMA(ai, bj, At, Bt) do { __builtin_amdgcn_s_setprio(1); _Pragma("unroll") for (int m = 0; m < 4; ++m) _Pragma("unroll") for (int n = 0; n < 2; ++n) _Pragma("unroll") for (int k = 0; k < 2; ++k) \
        acc[ai][bj][m][n] = __builtin_amdgcn_mfma_f32_16x16x32_bf16(Bt[n][k], At[m][k], acc[ai][bj][m][n], 0, 0, 0); __builtin_amdgcn_s_setprio(0); } while (0)
#define PG8_WAIT_V(n) asm volatile("s_waitcnt vmcnt(" #n ")" ::: "memory")
#define PG8_WAIT_L(n) asm volatile("s_waitcnt lgkmcnt(" #n ")" ::: "memory")
#define PG8_BAR __builtin_amdgcn_s_barrier()
#define PG8_SCHED __builtin_amdgcn_sched_barrier(0)
    Unit cur, nxt; int ui = 0;
    if (!S.next(0, cur)) return;
    f32x4 acc[2][2][4][2];
#pragma unroll
    for (int a = 0; a < 2; ++a)
#pragma unroll
        for (int b = 0; b < 2; ++b)
#pragma unroll
            for (int m = 0; m < 4; ++m)
#pragma unroll
                for (int n = 0; n < 2; ++n) acc[a][b][m][n] = (f32x4){0.f, 0.f, 0.f, 0.f};
    bf16x8 At[4][2], B0[2][2], B1[2][2];
    const char* cA = (const char*)g.A + (size_t)cur.pm * tstep; const char* cB = (const char*)g.Bt + (size_t)cur.pn * tstep;
    S.a_ready(cur);
    if constexpr (SP2) {
        PG8_STAGE(PG8_SB(0, 0), cB, voffB); PG8_STAGE(PG8_SB(0, 1), cB + hstep, voffB); PG8_STAGE(PG8_SA(0, 0), cA, voffA); PG8_STAGE(PG8_SA(0, 1), cA + hstep, voffA);
        if (wr == 1) PG8_BAR;
        PG8_WAIT_V(2); PG8_BAR;
        PG8_STAGE(PG8_SB(1, 0), cB + kstep, voffB); PG8_STAGE(PG8_SA(1, 0), cA + kstep, voffA); PG8_STAGE(PG8_SB(1, 1), cB + hstep + kstep, voffB);
        PG8_WAIT_V(6); PG8_BAR;
    } else {
        PG8_STAGE(PG8_SB(0, 0), cB, voffB); PG8_STAGE(PG8_SA(0, 0), cA, voffA); PG8_STAGE(PG8_SB(0, 1), cB + hstep, voffB); PG8_STAGE(PG8_SA(0, 1), cA + hstep, voffA);
        if (wr == 1) PG8_BAR;
        PG8_WAIT_V(4); PG8_BAR;
        PG8_STAGE(PG8_SB(1, 0), cB + kstep, voffB); PG8_STAGE(PG8_SA(1, 0), cA + kstep, voffA); PG8_STAGE(PG8_SB(1, 1), cB + hstep + kstep, voffB);
        PG8_WAIT_V(6); PG8_BAR;
    }
    for (;;) {
        const bool has_next = S.next(ui + 1, nxt);
        const char* nA = has_next ? (const char*)g.A + (size_t)nxt.pm * tstep : cA; const char* nB = has_next ? (const char*)g.Bt + (size_t)nxt.pn * tstep : cB;
        for (int t = 0; t < nt; t += 2) {
            const bool last = (t == nt - 2);
            const char* a1 = cA + (size_t)(t + 1) * kstep;
            const char* a2 = last ? nA : cA + (size_t)(t + 2) * kstep; const char* b2 = last ? nB : cB + (size_t)(t + 2) * kstep;
            const char* a3 = a2 + kstep; const char* b3 = b2 + kstep;
            if (last && has_next) S.a_ready(nxt);
            if constexpr (SP2) {
            PG8_LDB(B0, 0, 0); PG8_LDB(B1, 0, 1); PG8_SCHED; PG8_LDA(At, 0, 0); PG8_STAGE(PG8_SA(1, 1), a1 + hstep, voffA);
            PG8_WAIT_V(8); PG8_WAIT_L(0); PG8_BAR; PG8_MMA(0, 0, At, B0); PG8_MMA(0, 1, At, B1); PG8_BAR; PG8_SCHED;
            PG8_LDA(At, 0, 1); PG8_STAGE(PG8_SB(0, 0), b2, voffB); PG8_STAGE(PG8_SB(0, 1), b2 + hstep, voffB); PG8_STAGE(PG8_SA(0, 0), a2, voffA);
            PG8_WAIT_V(8); PG8_WAIT_L(0); PG8_BAR; PG8_MMA(1, 0, At, B0); PG8_MMA(1, 1, At, B1); PG8_BAR; PG8_SCHED;
            PG8_LDB(B0, 1, 0); PG8_LDB(B1, 1, 1); PG8_SCHED; PG8_LDA(At, 1, 0); PG8_STAGE(PG8_SA(0, 1), a2 + hstep, voffA);
            PG8_WAIT_V(8); PG8_WAIT_L(0); PG8_BAR; PG8_MMA(0, 0, At, B0); PG8_MMA(0, 1, At, B1); PG8_BAR; PG8_SCHED;
            PG8_LDA(At, 1, 1); PG8_STAGE(PG8_SB(1, 0), b3, voffB); PG8_STAGE(PG8_SB(1, 1), b3 + hstep, voffB); PG8_STAGE(PG8_SA(1, 0), a3, voffA);
            PG8_WAIT_V(8); PG8_WAIT_L(0); PG8_BAR; PG8_MMA(1, 0, At, B0); PG8_MMA(1, 1, At, B1); PG8_BAR; PG8_SCHED;
            } else {
            PG8_LDB(B0, 0, 0); PG8_SCHED; PG8_LDA(At, 0, 0); PG8_STAGE(PG8_SA(1, 1), a1 + hstep, voffA);
            PG8_WAIT_L(8); PG8_BAR; PG8_WAIT_L(0); PG8_MMA(0, 0, At, B0); PG8_BAR; PG8_SCHED;
            PG8_LDB(B1, 0, 1); PG8_STAGE(PG8_SB(0, 0), b2, voffB);
            PG8_BAR; PG8_WAIT_L(0); PG8_MMA(0, 1, At, B1); PG8_BAR;
            PG8_LDA(At, 0, 1); PG8_STAGE(PG8_SA(0, 0), a2, voffA);
            PG8_BAR; PG8_WAIT_L(0); PG8_MMA(1, 0, At, B0); PG8_BAR; PG8_SCHED;
            PG8_STAGE(PG8_SB(0, 1), b2 + hstep, voffB);
            PG8_WAIT_V(6); PG8_BAR; PG8_MMA(1, 1, At, B1); PG8_BAR;
            PG8_LDB(B0, 1, 0); PG8_SCHED; PG8_LDA(At, 1, 0); PG8_STAGE(PG8_SA(0, 1), a2 + hstep, voffA);
            PG8_WAIT_L(8); PG8_BAR; PG8_WAIT_L(0); PG8_MMA(0, 0, At, B0); PG8_BAR; PG8_SCHED;
            PG8_LDB(B1, 1, 1); PG8_STAGE(PG8_SB(1, 0), b3, voffB);
            PG8_BAR; PG8_WAIT_L(0); PG8_MMA(0, 1, At, B1); PG8_BAR;
            PG8_LDA(At, 1, 1); PG8_STAGE(PG8_SA(1, 0), a3, voffA);
            PG8_BAR; PG8_WAIT_L(0); PG8_MMA(1, 0, At, B0); PG8_BAR; PG8_SCHED;
            PG8_STAGE(PG8_SB(1, 1), b3 + hstep, voffB);
            PG8_WAIT_V(6); PG8_BAR; PG8_MMA(1, 1, At, B1); PG8_BAR;
            }
        }
        if constexpr (ALIGN_EPI) { if (wr == 0) PG8_BAR; }
        if constexpr (!Epi::AFTER_DRAIN) { E(acc, cur, wr, wc, fr, fq); S.done(cur); }
        if (!has_next) break;
#pragma unroll
        for (int a = 0; a < 2; ++a)
#pragma unroll
            for (int b = 0; b < 2; ++b)
#pragma unroll
                for (int m = 0; m < 4; ++m)
#pragma unroll
                    for (int n = 0; n < 2; ++n) acc[a][b][m][n] = (f32x4){0.f, 0.f, 0.f, 0.f};
        cur = nxt; cA = nA; cB = nB; ++ui;
        if constexpr (ALIGN_EPI) { if (wr == 1) PG8_BAR; }
    }
    PG8_WAIT_V(0);
    if constexpr (!ALIGN_EPI) { if (wr == 0) PG8_BAR; }
    PG8_BAR;
    if constexpr (Epi::AFTER_DRAIN) { E.fused(acc, cur, wr, wc, fr, fq, lds, wid, lane); S.done(cur); }
#undef PG8_SA
#undef PG8_SB
#undef PG8_STAGE
#undef PG8_LDA
#undef PG8_LDB
#undef PG8_MMA
#undef PG8_WAIT_V
#undef PG8_WAIT_L
#undef PG8_BAR
#undef PG8_SCHED
}
}

using pg8::bf16_t; using pg8::bf16x8; using pg8::f32x4; using pg8::u32x4; using pg8::cvt_pk_bf16;
typedef short s16x4 __attribute__((ext_vector_type(4)));
typedef float f32x16 __attribute__((ext_vector_type(16)));
constexpr int TP = 65536, TS = 128, TOK = TP + TS, TOKP = 65792;
constexpr int KVS = 2064, KVR = TP + 8 * KVS, KVRP = 82176;
constexpr int NIN = 1792, DFF = 2816, DFF2 = 5632;
constexpr float ALPHA = 1.189207115002721f;
constexpr float QSCALE = 0.07216878364870323f * 1.4426950408889634f;
constexpr long O_YP = 0, O_CKVP = 67239936L, O_KPEP = 84017152L, O_FCP = 88211456L, O_CKVS = 88301568L, O_KPES = 88334336L, O_GVS = 88342528L, O_FCS = 88408064L, O_END = 88498176L;
constexpr int LDS_BYTES = 131072;
constexpr size_t al256(size_t x) { return (x + 255) / 256 * 256; }
constexpr size_t WS_WIN = 0;
constexpr size_t WS_WUQ = WS_WIN + al256((size_t)NIN * 1024 * 2);
constexpr size_t WS_WKV = WS_WUQ + al256((size_t)768 * 384 * 2);
constexpr size_t WS_WO  = WS_WKV + al256((size_t)1024 * 256 * 2);
constexpr size_t WS_WUP = WS_WO + al256((size_t)1024 * 1024 * 2);
constexpr size_t WS_WDN = WS_WUP + al256((size_t)DFF2 * 1024 * 2);
constexpr size_t WS_WSP = WS_WDN + al256((size_t)1024 * DFF * 2);
constexpr size_t WS_WSS = WS_WSP + al256((size_t)4 * 128 * 128 * 2);
constexpr size_t WS_ROPE = WS_WSS + al256((size_t)4 * 128 * 128 * 2);
constexpr size_t WS_PROJ = WS_ROPE + al256((size_t)8192 * 32 * 8);
constexpr size_t WS_H = WS_PROJ;
constexpr size_t WS_XB = WS_PROJ + al256((size_t)TOKP * NIN * 2);
constexpr size_t WS_VN = WS_XB;
constexpr size_t WS_CQN = WS_VN + al256((size_t)TOKP * 512 * 2);
constexpr size_t WS_CKVN = WS_XB + al256((size_t)TOKP * 1024 * 2);
constexpr size_t WS_KPE = WS_CKVN + al256((size_t)KVRP * 256 * 2);
constexpr size_t WS_QB = WS_KPE + al256((size_t)KVRP * 64 * 2);
constexpr size_t WS_KVB = WS_QB + al256((size_t)TOKP * 768 * 2);
constexpr size_t WS_R1 = WS_KVB;
constexpr size_t WS_CAT = WS_KVB + al256((size_t)KVRP * 1024 * 2);
constexpr size_t WS_END = WS_CAT + al256((size_t)TOKP * 1024 * 2);
constexpr size_t WS_BAR = WS_END;
constexpr size_t WS_TOTAL = WS_BAR + 16384;
constexpr size_t WS_ACT = WS_XB;
constexpr size_t WS_BND = WS_ACT + al256((size_t)TOKP * DFF * 2);
constexpr size_t WS_UPS = WS_BND + al256((size_t)1024 * 4 * DFF2 * 2);
static_assert(WS_UPS + (size_t)128 * DFF2 * 2 <= WS_END, "FFN overlay does not fit");
static_assert(WS_CQN + (size_t)TOKP * 384 * 2 <= WS_CKVN, "VN+CQN overlay does not fit");

struct Params { const float* in[24]; float* out; unsigned char* ws; int ph_lo, ph_hi; };

__device__ __forceinline__ float bf2f(unsigned short h) { return __uint_as_float((unsigned)h << 16); }
__device__ __forceinline__ unsigned short f2bf(float f) { return (unsigned short)(cvt_pk_bf16(f, 0.f) & 0xffffu); }
__device__ __forceinline__ float blo(unsigned w) { return __uint_as_float(w << 16); }
__device__ __forceinline__ float bhi(unsigned w) { return __uint_as_float(w & 0xffff0000u); }
__device__ __forceinline__ float wsum(float v) {
#pragma unroll
    for (int o = 32; o > 0; o >>= 1) v += __shfl_xor(v, o);
    return v; }
__device__ __forceinline__ float gelu_tanh(float x) {
    const float u = 0.7978845608028654f * (x + 0.044715f * x * x * x);
    const float t = __builtin_amdgcn_exp2f(-2.885390081777927f * u);
    return x * __builtin_amdgcn_rcpf(1.f + t); }
__device__ __forceinline__ float silu(float x) { return x * __builtin_amdgcn_rcpf(1.f + __builtin_amdgcn_exp2f(-1.4426950408889634f * x)); }
__device__ __forceinline__ int rope_phys(int Ld) { const int nn = Ld >> 5, i = Ld & 31; return (i >> 4) * 32 + ((i & 15) >> 2) * 8 + nn * 4 + (i & 3); }
__device__ __forceinline__ int tok_pos(int row) { return row < TP ? (row & 8191) : (2048 + (row & 15)); }

namespace pg8 {
struct EpiPlain {
    static constexpr bool PERM = true, AFTER_DRAIN = false;
    bf16_t* O; int ldc; int gelu_tiles; float scale;
    __device__ __forceinline__ void operator()(const f32x4 (&acc)[2][2][4][2], const Unit& u, int wr, int wc, int fr, int fq) const {
        const int row0 = u.pm * BM + wr * 64 + fr, col0 = u.pn * BM + wc * 32 + 8 * fq; const bool g = u.pn < gelu_tiles;
#pragma unroll
        for (int ai = 0; ai < 2; ++ai)
#pragma unroll
            for (int m = 0; m < 4; ++m) { bf16_t* rowp = O + (size_t)(row0 + ai * HALF + m * 16) * ldc + col0;
#pragma unroll
                for (int bj = 0; bj < 2; ++bj) { f32x4 v0 = acc[ai][bj][m][0], v1 = acc[ai][bj][m][1];
                    if (g) {
#pragma unroll
                        for (int e = 0; e < 4; ++e) { v0[e] = gelu_tanh(v0[e]); v1[e] = gelu_tanh(v1[e]); } }
                    v0 = v0 * scale; v1 = v1 * scale;
                    u32x4 w; w.x = cvt_pk_bf16(v0[0], v0[1]); w.y = cvt_pk_bf16(v0[2], v0[3]); w.z = cvt_pk_bf16(v1[0], v1[1]); w.w = cvt_pk_bf16(v1[2], v1[3]);
                    *(u32x4*)(rowp + bj * HALF) = w; } }
    }
};
struct EpiQ {
    static constexpr bool PERM = true, AFTER_DRAIN = false;
    bf16_t* O; const float* rope;
    __device__ __forceinline__ void operator()(const f32x4 (&acc)[2][2][4][2], const Unit& u, int wr, int wc, int fr, int fq) const {
        const int row0 = u.pm * BM + wr * 64 + fr, col0 = u.pn * BM + wc * 32 + 8 * fq;
#pragma unroll
        for (int ai = 0; ai < 2; ++ai)
#pragma unroll
            for (int m = 0; m < 4; ++m) { const int row = row0 + ai * HALF + m * 16; bf16_t* rowp = O + (size_t)row * 768 + col0; const int pos = tok_pos(row);
#pragma unroll
                for (int bj = 0; bj < 2; ++bj) { f32x4 v0 = acc[ai][bj][m][0], v1 = acc[ai][bj][m][1];
                    const int within = (u.pn * BM + bj * HALF + wc * 32) % 192;
                    if (within >= 128) { const int i0 = ((within - 128) >> 5) * 16 + fq * 4; const float* rp = rope + ((size_t)pos * 32 + i0) * 2;
                        const f32x4 c01 = *(const f32x4*)rp, c23 = *(const f32x4*)(rp + 4);
                        const float cs[4] = {c01[0], c01[2], c23[0], c23[2]}, sn[4] = {c01[1], c01[3], c23[1], c23[3]};
#pragma unroll
                        for (int e = 0; e < 4; ++e) { const float x1 = v0[e], x2 = v1[e]; v0[e] = x1 * cs[e] - x2 * sn[e]; v1[e] = x2 * cs[e] + x1 * sn[e]; } }
                    v0 = v0 * QSCALE; v1 = v1 * QSCALE;
                    u32x4 w; w.x = cvt_pk_bf16(v0[0], v0[1]); w.y = cvt_pk_bf16(v0[2], v0[3]); w.z = cvt_pk_bf16(v1[0], v1[1]); w.w = cvt_pk_bf16(v1[2], v1[3]);
                    *(u32x4*)(rowp + bj * HALF) = w; }
                __builtin_amdgcn_sched_barrier(0); }
    }
};
struct EpiWo {
    static constexpr bool PERM = true, AFTER_DRAIN = false;
    bf16_t* O; const float* xp; const float* xs;
    __device__ __forceinline__ void operator()(const f32x4 (&acc)[2][2][4][2], const Unit& u, int wr, int wc, int fr, int fq) const {
        const int row0 = u.pm * BM + wr * 64 + fr, col0 = u.pn * BM + wc * 32 + 8 * fq;
#pragma unroll
        for (int ai = 0; ai < 2; ++ai)
#pragma unroll
            for (int m = 0; m < 4; ++m) { const int row = row0 + ai * HALF + m * 16; if (row >= TOK) continue;
                const float* xr = (row < TP ? xp + (size_t)row * 1024 : xs + (size_t)(row - TP) * 1024) + col0; bf16_t* rowp = O + (size_t)row * 1024 + col0;
#pragma unroll
                for (int bj = 0; bj < 2; ++bj) { const f32x4 a = *(const f32x4*)(xr + bj * HALF), b = *(const f32x4*)(xr + bj * HALF + 4);
                    const f32x4 v0 = acc[ai][bj][m][0] + a * ALPHA, v1 = acc[ai][bj][m][1] + b * ALPHA;
                    u32x4 w; w.x = cvt_pk_bf16(v0[0], v0[1]); w.y = cvt_pk_bf16(v0[2], v0[3]); w.z = cvt_pk_bf16(v1[0], v1[1]); w.w = cvt_pk_bf16(v1[2], v1[3]);
                    *(u32x4*)(rowp + bj * HALF) = w; } }
    }
};
struct EpiDown {
    static constexpr bool PERM = true, AFTER_DRAIN = false;
    float* Y; const bf16_t* H;
    __device__ __forceinline__ void operator()(const f32x4 (&acc)[2][2][4][2], const Unit& u, int wr, int wc, int fr, int fq) const {
        const int row0 = u.pm * BM + wr * 64 + fr, col0 = u.pn * BM + wc * 32 + 8 * fq;
#pragma unroll
        for (int ai = 0; ai < 2; ++ai)
#pragma unroll
            for (int m = 0; m < 4; ++m) { const int row = row0 + ai * HALF + m * 16; if (row >= TOK) continue;
                const bf16_t* hr = H + (size_t)row * 1024 + col0; float* yr = Y + (size_t)row * 1024 + col0;
#pragma unroll
                for (int bj = 0; bj < 2; ++bj) { const u32x4 hw = *(const u32x4*)(hr + bj * HALF);
                    f32x4 v0 = acc[ai][bj][m][0], v1 = acc[ai][bj][m][1];
                    v0[0] += ALPHA * blo(hw.x); v0[1] += ALPHA * bhi(hw.x); v0[2] += ALPHA * blo(hw.y); v0[3] += ALPHA * bhi(hw.y);
                    v1[0] += ALPHA * blo(hw.z); v1[1] += ALPHA * bhi(hw.z); v1[2] += ALPHA * blo(hw.w); v1[3] += ALPHA * bhi(hw.w);
                    *(f32x4*)(yr + bj * HALF) = v0; *(f32x4*)(yr + bj * HALF + 4) = v1; } }
    }
};
__device__ __forceinline__ float dpp_ror1(float v) { return __int_as_float(__builtin_amdgcn_update_dpp(0, __float_as_int(v), 0x121, 0xF, 0xF, false)); }
__device__ __forceinline__ float dpp_ror2(float v) { return __int_as_float(__builtin_amdgcn_update_dpp(0, __float_as_int(v), 0x122, 0xF, 0xF, false)); }
struct EpiUpConv {
    static constexpr bool PERM = true, AFTER_DRAIN = false;
    bf16_t* ACT; bf16_t* BND; bf16_t* UPS; const float* wcv; const float* bcv;
    __device__ __forceinline__ void operator()(const f32x4 (&acc)[2][2][4][2], const Unit& u, int wr, int wc, int fr, int fq) const {
        const int f0 = u.pn * 128 + wc * 32 + 8 * fq;
        if (u.pm == 256) {
#pragma unroll
            for (int m = 0; m < 4; ++m) { const int row = wr * 64 + m * 16 + fr;
#pragma unroll
                for (int bj = 0; bj < 2; ++bj) { const f32x4 v0 = acc[0][bj][m][0], v1 = acc[0][bj][m][1]; u32x4 w;
                    w.x = cvt_pk_bf16(v0[0], v0[1]); w.y = cvt_pk_bf16(v0[2], v0[3]); w.z = cvt_pk_bf16(v1[0], v1[1]); w.w = cvt_pk_bf16(v1[2], v1[3]);
                    *(u32x4*)((char*)UPS + ((unsigned)row * 5632u + (unsigned)(bj * 2816 + f0)) * 2u) = w; } }
            return;
        }
#pragma unroll
        for (int ai = 0; ai < 2; ++ai) {
            const int slab = u.pm * 4 + ai * 2 + wr;
            if (fr < 2 || fr >= 14) { const int m = fr < 2 ? 0 : 3; const int ri = fr < 2 ? fr : fr - 12;
#pragma unroll
                for (int bj = 0; bj < 2; ++bj) { const f32x4 v0 = fr < 2 ? acc[ai][bj][0][0] : acc[ai][bj][3][0], v1 = fr < 2 ? acc[ai][bj][0][1] : acc[ai][bj][3][1]; u32x4 w;
                    w.x = cvt_pk_bf16(v0[0], v0[1]); w.y = cvt_pk_bf16(v0[2], v0[3]); w.z = cvt_pk_bf16(v1[0], v1[1]); w.w = cvt_pk_bf16(v1[2], v1[3]);
                    *(u32x4*)((char*)BND + ((unsigned)(slab * 4 + ri) * 5632u + (unsigned)(bj * 2816 + f0)) * 2u) = w; }
                (void)m; }
            const bool g1 = fr >= 1, g2 = fr >= 2;
#pragma unroll
            for (int n = 0; n < 2; ++n) {
                unsigned pk[4][2];
                float aprev[4];
#pragma unroll
                for (int e = 0; e < 4; ++e) {
                    const char* wb = (const char*)wcv + (unsigned)(f0 + 4 * n + e) * 4u; const char* bbp = (const char*)bcv + (unsigned)(f0 + 4 * n + e) * 4u;
                    float cv[2][4];
#pragma unroll
                    for (int bj = 0; bj < 2; ++bj) {
                        const float w0 = *(const float*)(wb + bj * 2816 * 4), w1 = *(const float*)(wb + (5632 + bj * 2816) * 4), w2 = *(const float*)(wb + (2 * 5632 + bj * 2816) * 4), bb = *(const float*)(bbp + bj * 2816 * 4);
                        const float v0 = acc[ai][bj][0][n][e], v1 = acc[ai][bj][1][n][e], v2 = acc[ai][bj][2][n][e], v3 = acc[ai][bj][3][n][e];
                        const float a0 = dpp_ror1(v0), a1 = dpp_ror1(v1), a2 = dpp_ror1(v2), a3 = dpp_ror1(v3);
                        const float c0 = dpp_ror2(v0), c1 = dpp_ror2(v1), c2 = dpp_ror2(v2), c3 = dpp_ror2(v3);
                        cv[bj][0] = bb + w2 * v0 + w1 * a0 + w0 * c0;
                        cv[bj][1] = bb + w2 * v1 + w1 * (g1 ? a1 : a0) + w0 * (g2 ? c1 : c0);
                        cv[bj][2] = bb + w2 * v2 + w1 * (g1 ? a2 : a1) + w0 * (g2 ? c2 : c1);
                        cv[bj][3] = bb + w2 * v3 + w1 * (g1 ? a3 : a2) + w0 * (g2 ? c3 : c2); }
#pragma unroll
                    for (int m = 0; m < 4; ++m) { const float a = cv[0][m]; const float r = a * __builtin_amdgcn_rcpf(1.f + __builtin_amdgcn_exp2f(-1.4426950408889634f * a)) * cv[1][m];
                        if (e & 1) pk[m][e >> 1] = cvt_pk_bf16(aprev[m], r); else aprev[m] = r; }
                    __builtin_amdgcn_sched_barrier(0);
                }
#pragma unroll
                for (int m = 0; m < 4; ++m) { if (m == 0 && fr < 2) continue;
                    const int row = u.pm * BM + ai * HALF + wr * 64 + m * 16 + fr;
                    unsigned* dst = (unsigned*)((char*)ACT + ((unsigned)row * 2816u + (unsigned)(f0 + 4 * n)) * 2u);
                    typedef unsigned u32x2 __attribute__((ext_vector_type(2)));
                    *(u32x2*)dst = (u32x2){pk[m][0], pk[m][1]}; }
                __builtin_amdgcn_sched_barrier(0);
            }
        }
    }
};
}

__device__ void transpose_job(const float* __restrict__ src, int K, int N, bf16_t* __restrict__ dst, int mode, int rowoff, float* tile) {
    const int tid = threadIdx.x, ntn = N / 64, ntot = (K / 64) * ntn;
    for (int tix = blockIdx.x; tix < ntot; tix += gridDim.x) {
        const int kt = tix / ntn, nt = tix % ntn;
        __syncthreads();
#pragma unroll
        for (int i = 0; i < 8; ++i) { const int r = (tid >> 6) + 8 * i, c = tid & 63; tile[r * 65 + c] = src[(size_t)(kt * 64 + r) * N + nt * 64 + c]; }
        __syncthreads();
        const int nn = tid >> 3, kk = (tid & 7) * 8, n = nt * 64 + nn; int drow = n;
        if (mode == 1) { const int h = n / 192, d = n % 192; drow = d < 128 ? n : h * 192 + 128 + rope_phys(d - 128); }
        if (mode == 2) { const int part = n / DFF, f = n % DFF; drow = (f >> 7) * 256 + part * 128 + (f & 127); }
        float v[8];
#pragma unroll
        for (int e = 0; e < 8; ++e) v[e] = tile[(kk + e) * 65 + nn];
        u32x4 w; w.x = cvt_pk_bf16(v[0], v[1]); w.y = cvt_pk_bf16(v[2], v[3]); w.z = cvt_pk_bf16(v[4], v[5]); w.w = cvt_pk_bf16(v[6], v[7]);
        *(u32x4*)(dst + (size_t)(drow + rowoff) * K + kt * 64 + kk) = w;
    }
}
__device__ void p0_prologue(const Params& P, unsigned char* lds) {
    const int tid = threadIdx.x; const long gtid = blockIdx.x * 512L + tid, gsz = gridDim.x * 512L;
    unsigned char* ws = P.ws;
    {
        bf16_t* XB = (bf16_t*)(ws + WS_XB); const long n8 = (long)TOKP * 1024 / 8;
        for (long i = gtid; i < n8; i += gsz) { const long e = i * 8, row = e >> 10; u32x4 w = {0u, 0u, 0u, 0u};
            if (row < TOK) { const float* s = row < TP ? P.in[0] + e : P.in[1] + (e - (long)TP * 1024);
                const f32x4 a = *(const f32x4*)s, b = *(const f32x4*)(s + 4);
                w.x = cvt_pk_bf16(a[0], a[1]); w.y = cvt_pk_bf16(a[2], a[3]); w.z = cvt_pk_bf16(b[0], b[1]); w.w = cvt_pk_bf16(b[2], b[3]); }
            *(u32x4*)(XB + e) = w; }
    }
    {
        bf16_t* CK = (bf16_t*)(ws + WS_CKVN); const long n8 = 8L * 2048 * 256 / 8;
        for (long i = gtid; i < n8; i += gsz) { const long e = i * 8; const int r = (int)(e >> 8), c = (int)(e & 255), b = r >> 11, p = r & 2047;
            const float* s = P.in[2] + e; const f32x4 a = *(const f32x4*)s, bb = *(const f32x4*)(s + 4); u32x4 w;
            w.x = cvt_pk_bf16(a[0], a[1]); w.y = cvt_pk_bf16(a[2], a[3]); w.z = cvt_pk_bf16(bb[0], bb[1]); w.w = cvt_pk_bf16(bb[2], bb[3]);
            *(u32x4*)(CK + (size_t)(TP + b * KVS + p) * 256 + c) = w; }
        for (long i = gtid; i < (long)(KVRP - KVR) * 256; i += gsz) CK[(size_t)KVR * 256 + i] = 0;
        bf16_t* KP = (bf16_t*)(ws + WS_KPE);
        for (long i = gtid; i < 8L * 2048 * 64; i += gsz) { const int r = (int)(i >> 6), d = (int)(i & 63), b = r >> 11, p = r & 2047;
            KP[(size_t)(TP + b * KVS + p) * 64 + rope_phys(d)] = f2bf(P.in[3][i]); }
        for (long i = gtid; i < (long)(KVRP - KVR) * 64; i += gsz) KP[(size_t)KVR * 64 + i] = 0;
    }
    {
        float* RT = (float*)(ws + WS_ROPE);
        for (long i = gtid; i < 8192L * 32; i += gsz) { const int pos = (int)(i >> 5), k = (int)(i & 31);
            const float invf = exp2f(-(float)k * (13.287712379549449f / 32.f)); const float ang = (float)pos * invf;
            double rev = (double)ang * 0.15915494309189535; rev -= floor(rev); const float fr = (float)rev;
            RT[i * 2] = __builtin_amdgcn_cosf(fr); RT[i * 2 + 1] = __builtin_amdgcn_sinf(fr); }
    }
    {
        bf16_t* WP = (bf16_t*)(ws + WS_WSP); bf16_t* WS_ = (bf16_t*)(ws + WS_WSS); const float* w_s = P.in[8];
        for (long i = gtid; i < 4L * 128 * 128; i += gsz) { const int h = (int)(i >> 14), r = (int)(i >> 7) & 127, c = (int)i & 127;
            WP[i] = ((c >> 6) <= (r >> 6)) ? f2bf(w_s[i]) : (bf16_t)0;
            WS_[i] = ((r >> 4) == (c >> 4)) ? f2bf(w_s[h * 16384 + (r & 15) * 128 + (c & 15)]) : (bf16_t)0; }
        bf16_t* WI = (bf16_t*)(ws + WS_WIN);
        for (long i = gtid; i < 64L * 1024; i += gsz) WI[(size_t)1728 * 1024 + i] = 0;
    }
    float* tile = (float*)lds;
    transpose_job(P.in[5], 1024, 1728, (bf16_t*)(ws + WS_WIN), 0, 0, tile);
    transpose_job(P.in[11], 384, 768, (bf16_t*)(ws + WS_WUQ), 1, 0, tile);
    transpose_job(P.in[13], 256, 512, (bf16_t*)(ws + WS_WKV), 0, 0, tile);
    transpose_job(P.in[14], 256, 512, (bf16_t*)(ws + WS_WKV), 0, 512, tile);
    transpose_job(P.in[15], 1024, 1024, (bf16_t*)(ws + WS_WO), 0, 0, tile);
    transpose_job(P.in[18], 1024, DFF2, (bf16_t*)(ws + WS_WUP), 2, 0, tile);
    transpose_job(P.in[21], DFF, 1024, (bf16_t*)(ws + WS_WDN), 0, 0, tile);
    __syncthreads();
}

__device__ void p2_token(const Params& P) {
    unsigned char* ws = P.ws; const int lane = threadIdx.x & 63; const int gw = blockIdx.x * 8 + (threadIdx.x >> 6), nw = gridDim.x * 8;
    const bf16_t* PROJ = (const bf16_t*)(ws + WS_PROJ); bf16_t* VN = (bf16_t*)(ws + WS_VN); bf16_t* CQN = (bf16_t*)(ws + WS_CQN);
    bf16_t* CK = (bf16_t*)(ws + WS_CKVN); bf16_t* KP = (bf16_t*)(ws + WS_KPE); const float* RT = (const float*)(ws + WS_ROPE);
    const float* lng = P.in[6]; const float* lnb = P.in[7]; const float* gq = P.in[10]; const float* gkv = P.in[12];
    float g8[8], b8[8];
#pragma unroll
    for (int e = 0; e < 8; ++e) { g8[e] = lng[lane * 8 + e]; b8[e] = lnb[lane * 8 + e]; }
    float gq6[6], gk4[4];
#pragma unroll
    for (int i = 0; i < 3; ++i) { gq6[2 * i] = gq[128 * i + 2 * lane]; gq6[2 * i + 1] = gq[128 * i + 2 * lane + 1]; }
#pragma unroll
    for (int e = 0; e < 4; ++e) gk4[e] = gkv[lane * 4 + e];
    const int kphys = rope_phys(lane);
    for (int t = gw; t < TOK; t += nw) {
        const bf16_t* pr = PROJ + (size_t)t * NIN;
        const int kvrow = t < TP ? t : TP + ((t - TP) >> 4) * KVS + 2048 + (t & 15);
        {
            const u32x4 w = *(const u32x4*)(pr + 512 + lane * 8);
            float x[8] = {blo(w.x), bhi(w.x), blo(w.y), bhi(w.y), blo(w.z), bhi(w.z), blo(w.w), bhi(w.w)};
            float s = 0.f;
#pragma unroll
            for (int e = 0; e < 8; ++e) s += x[e];
            const float mu = wsum(s) * (1.f / 512.f); float q = 0.f;
#pragma unroll
            for (int e = 0; e < 8; ++e) { x[e] -= mu; q += x[e] * x[e]; }
            const float rstd = rsqrtf(wsum(q) * (1.f / 512.f) + 1e-5f);
#pragma unroll
            for (int e = 0; e < 8; ++e) x[e] = x[e] * rstd * g8[e] + b8[e];
            u32x4 o; o.x = cvt_pk_bf16(x[0], x[1]); o.y = cvt_pk_bf16(x[2], x[3]); o.z = cvt_pk_bf16(x[4], x[5]); o.w = cvt_pk_bf16(x[6], x[7]);
            *(u32x4*)(VN + (size_t)t * 512 + lane * 8) = o;
            if (t >= TP) { float* go = P.out + O_GVS + (size_t)(t - TP) * 512 + lane * 8;
                *(f32x4*)go = (f32x4){x[0], x[1], x[2], x[3]}; *(f32x4*)(go + 4) = (f32x4){x[4], x[5], x[6], x[7]}; }
        }
        {
            float x[6]; float q = 0.f;
#pragma unroll
            for (int i = 0; i < 3; ++i) { const unsigned w = *(const unsigned*)(pr + 1024 + 128 * i + 2 * lane); x[2 * i] = blo(w); x[2 * i + 1] = bhi(w); q += x[2 * i] * x[2 * i] + x[2 * i + 1] * x[2 * i + 1]; }
            const float rstd = rsqrtf(wsum(q) * (1.f / 384.f) + 1e-6f);
#pragma unroll
            for (int i = 0; i < 3; ++i) *(unsigned*)(CQN + (size_t)t * 384 + 128 * i + 2 * lane) = cvt_pk_bf16(x[2 * i] * rstd * gq6[2 * i], x[2 * i + 1] * rstd * gq6[2 * i + 1]);
        }
        {
            const unsigned w0 = *(const unsigned*)(pr + 1408 + lane * 4), w1 = *(const unsigned*)(pr + 1408 + lane * 4 + 2);
            float x[4] = {blo(w0), bhi(w0), blo(w1), bhi(w1)};
            const float rstd = rsqrtf(wsum(x[0] * x[0] + x[1] * x[1] + x[2] * x[2] + x[3] * x[3]) * (1.f / 256.f) + 1e-6f);
#pragma unroll
            for (int e = 0; e < 4; ++e) x[e] = x[e] * rstd * gk4[e];
            float* co = P.out + (t < TP ? O_CKVP + (size_t)t * 256 : O_CKVS + (size_t)(t - TP) * 256) + lane * 4;
            *(f32x4*)co = (f32x4){x[0], x[1], x[2], x[3]};
            unsigned* ck = (unsigned*)(CK + (size_t)kvrow * 256 + lane * 4); ck[0] = cvt_pk_bf16(x[0], x[1]); ck[1] = cvt_pk_bf16(x[2], x[3]);
        }
        {
            const float x = bf2f(pr[1664 + lane]); const float other = __shfl_xor(x, 32); const int i = lane & 31, pos = tok_pos(t);
            const float c = RT[((size_t)pos * 32 + i) * 2], s = RT[((size_t)pos * 32 + i) * 2 + 1];
            const float o = lane < 32 ? x * c - other * s : x * c + other * s;
            P.out[(t < TP ? O_KPEP + (size_t)t * 64 : O_KPES + (size_t)(t - TP) * 64) + lane] = o;
            KP[(size_t)kvrow * 64 + kphys] = f2bf(o);
        }
    }
}

__device__ __forceinline__ int crow(int r, int hi) { return (r & 3) + 8 * (r >> 2) + 4 * hi; }
__device__ void spatial_phase(const Params& P, unsigned char* lds) {
    unsigned char* ws = P.ws; const int tid = threadIdx.x, wid = tid >> 6, lane = tid & 63, r32 = lane & 31, hi = lane >> 5;
    const bf16_t* PROJ = (const bf16_t*)(ws + WS_PROJ); const bf16_t* VN = (const bf16_t*)(ws + WS_VN); bf16_t* CAT = (bf16_t*)(ws + WS_CAT);
    bf16_t* VT = (bf16_t*)lds;
    const float* bs = P.in[9];
    for (int unit = blockIdx.x; unit < 513 * 4; unit += gridDim.x) {
        const int c = unit >> 2, h = unit & 3, tok0 = c * 128; const bool sample = (c == 512);
        const bf16_t* Wm = (const bf16_t*)(ws + (sample ? WS_WSS : WS_WSP)) + h * 16384;
        __syncthreads();
        {   const int j = tid >> 2, dq = (tid & 3) * 32; const bf16_t* src = VN + (size_t)(tok0 + j) * 512 + h * 128 + dq;
#pragma unroll
            for (int i = 0; i < 4; ++i) { const u32x4 w = *(const u32x4*)(src + 8 * i); const unsigned ww[4] = {w.x, w.y, w.z, w.w};
#pragma unroll
                for (int e = 0; e < 4; ++e) { VT[(dq + 8 * i + 2 * e) * 136 + j] = (bf16_t)(ww[e] & 0xffffu); VT[(dq + 8 * i + 2 * e + 1) * 136 + j] = (bf16_t)(ww[e] >> 16); } }
        }
        __syncthreads();
        const int ib = wid >> 1, db0 = (wid & 1) * 2;
        f32x16 a0 = {}, a1 = {};
#pragma unroll
        for (int k = 0; k < 8; ++k) {
            const bf16x8 a = *(const bf16x8*)(Wm + (ib * 32 + r32) * 128 + k * 16 + hi * 8);
            const bf16x8 b0 = *(const bf16x8*)(VT + (db0 * 32 + r32) * 136 + k * 16 + hi * 8);
            const bf16x8 b1 = *(const bf16x8*)(VT + ((db0 + 1) * 32 + r32) * 136 + k * 16 + hi * 8);
            a0 = __builtin_amdgcn_mfma_f32_32x32x16_bf16(a, b0, a0, 0, 0, 0);
            a1 = __builtin_amdgcn_mfma_f32_32x32x16_bf16(a, b1, a1, 0, 0, 0);
        }
#pragma unroll
        for (int r = 0; r < 16; ++r) { const int i = ib * 32 + crow(r, hi), tok = tok0 + i; const float bias = bs[h * 128 + (sample ? (i & 15) : i)];
            const int d0 = h * 128 + db0 * 32 + r32;
            const float u0 = bf2f(PROJ[(size_t)tok * NIN + d0]), u1 = bf2f(PROJ[(size_t)tok * NIN + d0 + 32]);
            CAT[(size_t)tok * 1024 + d0] = f2bf(u0 * (a0[r] + bias)); CAT[(size_t)tok * 1024 + d0 + 32] = f2bf(u1 * (a1[r] + bias)); }
    }
    __syncthreads();
}

namespace att {
constexpr int SHM_V = 16384, SHM_K = 16384, SHM_P = 8192;
constexpr int OFF_V = 0, OFF_K = 2 * SHM_V, OFF_P = OFF_K + 2 * SHM_K, OFF_WS = OFF_P + 2 * SHM_P;
#define KSWZ(row, colB) ((row) * 256 + ((colB) ^ (((row) & 7) << 4)))
#define PSWZ(row, colB) ((row) * 128 + ((colB) ^ (((row) & 7) << 4)))
#define SBAR() __builtin_amdgcn_sched_barrier(0)
__device__ __forceinline__ int v_st(int k, int c) { const int kk = (k & ~0xC) | ((k & 4) << 1) | ((k & 8) >> 1); return ((kk >> 3) * 4 + (c >> 5)) * 512 + ((kk & 7) * 32 + (c & 31)) * 2; }
__device__ __forceinline__ int v_rd_base(int lane) { return ((lane & 3) << 3) | (((lane >> 2) & 3) << 6) | (((lane >> 4) & 1) << 5) | (((lane >> 5) & 1) << 8); }
constexpr int v_rd_off(int d0, int ks, int half) { return d0 * 512 + ks * 4096 + half * 2048; }
template <int OFF> __device__ __forceinline__ s16x4 tr_read(int vb) {
    s16x4 r; asm volatile("ds_read_b64_tr_b16 %0, %1 offset:%2" : "=&v"(r) : "v"(vb), "i"(OFF) : "memory"); return r; }
template <int D0> __device__ __forceinline__ void pv_one(f32x16& od, int vb, bf16x8 pa0, bf16x8 pa1, bf16x8 pa2, bf16x8 pa3) {
    const s16x4 l0 = tr_read<v_rd_off(D0, 0, 0)>(vb), h0 = tr_read<v_rd_off(D0, 0, 1)>(vb), l1 = tr_read<v_rd_off(D0, 1, 0)>(vb), h1 = tr_read<v_rd_off(D0, 1, 1)>(vb);
    const s16x4 l2 = tr_read<v_rd_off(D0, 2, 0)>(vb), h2 = tr_read<v_rd_off(D0, 2, 1)>(vb), l3 = tr_read<v_rd_off(D0, 3, 0)>(vb), h3 = tr_read<v_rd_off(D0, 3, 1)>(vb);
    asm volatile("s_waitcnt lgkmcnt(0)" ::: "memory"); SBAR();
#define PK(L, H) (bf16x8){L[0], L[1], L[2], L[3], H[0], H[1], H[2], H[3]}
    od = __builtin_amdgcn_mfma_f32_32x32x16_bf16(pa0, PK(l0, h0), od, 0, 0, 0);
    od = __builtin_amdgcn_mfma_f32_32x32x16_bf16(pa1, PK(l1, h1), od, 0, 0, 0);
    od = __builtin_amdgcn_mfma_f32_32x32x16_bf16(pa2, PK(l2, h2), od, 0, 0, 0);
    od = __builtin_amdgcn_mfma_f32_32x32x16_bf16(pa3, PK(l3, h3), od, 0, 0, 0);
#undef PK
}
__device__ __forceinline__ void attn_unit(const bf16_t* __restrict__ Qrow  , const float* __restrict__ ropeRow  ,
                                          const bf16_t* __restrict__ KVh  ,
                                          const bf16_t* __restrict__ KPh  , bf16_t* __restrict__ Orow0  ,
                                          int orows  , int NT, int nact, int kvalid, unsigned char* lds) {
    const int tid = threadIdx.x, wid = __builtin_amdgcn_readfirstlane(tid >> 6), lane = tid & 63, r32 = lane & 31, hi = lane >> 5;
    unsigned char* V_lds = lds + OFF_V; unsigned char* K_lds = lds + OFF_K; unsigned char* P_lds = lds + OFF_P;
    float* wsf = (float*)(lds + OFF_WS) + wid * 64; float* li_l = wsf; float* al_l = wsf + 32;
    float m_reg = -1e30f, l_reg = 0.f; f32x16 o[4] = {}; bf16x8 qr[12];
#pragma unroll
    for (int d0 = 0; d0 < 12; ++d0) qr[d0] = *(const bf16x8*)(Qrow + hi * 8 + d0 * 16);
#pragma unroll
    for (int d0 = 0; d0 < 4; ++d0) {
        const int i0 = (d0 >> 1) * 16 + ((d0 & 1) * 2 + hi) * 4; const float* rp = ropeRow + i0 * 2;
        const f32x4 c01 = *(const f32x4*)rp, c23 = *(const f32x4*)(rp + 4);
        const float cs[4] = {c01[0], c01[2], c23[0], c23[2]}, sn[4] = {c01[1], c01[3], c23[1], c23[3]};
        const u32x4 w = *reinterpret_cast<const u32x4*>(&qr[8 + d0]);
        const float x1[4] = {blo(w.x), bhi(w.x), blo(w.y), bhi(w.y)}, x2[4] = {blo(w.z), bhi(w.z), blo(w.w), bhi(w.w)};
        float y1[4], y2[4];
#pragma unroll
        for (int e = 0; e < 4; ++e) { y1[e] = x1[e] * cs[e] - x2[e] * sn[e]; y2[e] = x2[e] * cs[e] + x1[e] * sn[e]; }
        u32x4 ow; ow.x = cvt_pk_bf16(y1[0], y1[1]); ow.y = cvt_pk_bf16(y1[2], y1[3]); ow.z = cvt_pk_bf16(y2[0], y2[1]); ow.w = cvt_pk_bf16(y2[2], y2[3]);
        qr[8 + d0] = *reinterpret_cast<bf16x8*>(&ow);
    }
    int kofs[2], vofs[2], pofs;
#pragma unroll
    for (int i = 0; i < 2; ++i) { const int c = wid + 8 * i;
        { const int row = 4 * c + (lane >> 4), colB = ((lane & 15) * 16) ^ ((row & 7) << 4); kofs[i] = row * 1024 + (colB >> 1); }
        { const int st = 2 * c + (lane >> 5), kk = (st >> 2) * 8 + ((lane & 31) >> 2), col = (st & 3) * 32 + (lane & 3) * 8;
          const int k = (kk & ~0xC) | ((kk & 4) << 1) | ((kk & 8) >> 1); vofs[i] = k * 1024 + 512 + col; } }
    { const int row = wid * 8 + (lane >> 3), colB = ((lane & 7) * 16) ^ ((row & 7) << 4); pofs = row * 64 + (colB >> 1); }
    const int vb0 = (int)(uintptr_t)(V_lds) + v_rd_base(lane);
#define GLDS(gp, lp) __builtin_amdgcn_global_load_lds((const unsigned*)(gp), (PG8_LAS unsigned*)(lp), 16, 0, 0)
#define STAGE_T(k0, b) do { const bf16_t* kb_ = KVh + (size_t)(k0) * 1024; \
        GLDS(kb_ + kofs[0], K_lds + (b) * SHM_K + wid * 1024); GLDS(kb_ + kofs[1], K_lds + (b) * SHM_K + (wid + 8) * 1024); \
        GLDS(kb_ + vofs[0], V_lds + (b) * SHM_V + wid * 1024); GLDS(kb_ + vofs[1], V_lds + (b) * SHM_V + (wid + 8) * 1024); \
        GLDS(KPh + (size_t)(k0) * 64 + pofs, P_lds + (b) * SHM_P + wid * 1024); } while (0)
    STAGE_T(0, 0); asm volatile("s_waitcnt vmcnt(0)" ::: "memory"); __syncthreads();
    for (int j = 0; j < NT; ++j) {
        const int buf = j & 1; const bool more = (j + 1 < NT);
        if (more) STAGE_T((j + 1) * 64, buf ^ 1);
        if (j < nact) {
            const unsigned char* Ks = K_lds + buf * SHM_K; const unsigned char* Ps = P_lds + buf * SHM_P;
            f32x16 p0 = {}, p1 = {};
#pragma unroll
            for (int d0 = 0; d0 < 8; ++d0) { const int cb = (d0 * 16 + hi * 8) * 2;
                const bf16x8 b0 = *(const bf16x8*)(Ks + KSWZ(r32, cb)), b1 = *(const bf16x8*)(Ks + KSWZ(32 + r32, cb));
                p0 = __builtin_amdgcn_mfma_f32_32x32x16_bf16(b0, qr[d0], p0, 0, 0, 0); p1 = __builtin_amdgcn_mfma_f32_32x32x16_bf16(b1, qr[d0], p1, 0, 0, 0); }
#pragma unroll
            for (int d0 = 0; d0 < 4; ++d0) { const int cb = (d0 * 16 + hi * 8) * 2;
                const bf16x8 b0 = *(const bf16x8*)(Ps + PSWZ(r32, cb)), b1 = *(const bf16x8*)(Ps + PSWZ(32 + r32, cb));
                p0 = __builtin_amdgcn_mfma_f32_32x32x16_bf16(b0, qr[8 + d0], p0, 0, 0, 0); p1 = __builtin_amdgcn_mfma_f32_32x32x16_bf16(b1, qr[8 + d0], p1, 0, 0, 0); }
            if (j == NT - 1 && kvalid < 64) {
#pragma unroll
                for (int r = 0; r < 16; ++r) { if (crow(r, hi) >= kvalid) p0[r] = -1e30f; if (32 + crow(r, hi) >= kvalid) p1[r] = -1e30f; } }
            float pmax = p0[0];
#pragma unroll
            for (int r = 1; r < 16; ++r) pmax = fmaxf(pmax, p0[r]);
#pragma unroll
            for (int r = 0; r < 16; ++r) pmax = fmaxf(pmax, p1[r]);
            { auto rr = __builtin_amdgcn_permlane32_swap(__float_as_uint(pmax), __float_as_uint(pmax), false, false); pmax = fmaxf(__uint_as_float(rr[0]), __uint_as_float(rr[1])); }
            const float mn = fmaxf(m_reg, pmax); const float alpha = __builtin_amdgcn_exp2f(m_reg - mn); m_reg = mn;
            float ps = 0.f;
#pragma unroll
            for (int r = 0; r < 16; ++r) { p0[r] = __builtin_amdgcn_exp2f(p0[r] - mn); p1[r] = __builtin_amdgcn_exp2f(p1[r] - mn); ps += p0[r] + p1[r]; }
            { auto rr = __builtin_amdgcn_permlane32_swap(__float_as_uint(ps), __float_as_uint(ps), false, false); ps = __uint_as_float(rr[0]) + __uint_as_float(rr[1]); }
            l_reg = l_reg * alpha + ps;
            bf16x8 pa0, pa1, pa2, pa3;
#define PK4(Pv, BASE, OUT) do { unsigned a0 = cvt_pk_bf16(Pv[BASE + 0], Pv[BASE + 1]), a1 = cvt_pk_bf16(Pv[BASE + 2], Pv[BASE + 3]); \
        unsigned b0_ = cvt_pk_bf16(Pv[BASE + 4], Pv[BASE + 5]), b1_ = cvt_pk_bf16(Pv[BASE + 6], Pv[BASE + 7]); \
        auto r0 = __builtin_amdgcn_permlane32_swap(a0, b0_, false, false); auto r1 = __builtin_amdgcn_permlane32_swap(a1, b1_, false, false); \
        u32x4 w_ = {r0[0], r1[0], r0[1], r1[1]}; OUT = *reinterpret_cast<bf16x8*>(&w_); } while (0)
            PK4(p0, 0, pa0); PK4(p0, 8, pa1); PK4(p1, 0, pa2); PK4(p1, 8, pa3);
#undef PK4
            if (__any(alpha < 1.f)) { if (hi == 0) al_l[r32] = alpha; asm volatile("s_waitcnt lgkmcnt(0)" ::: "memory");
#pragma unroll
                for (int r = 0; r < 16; ++r) { const float a = al_l[crow(r, hi)];
#pragma unroll
                    for (int d = 0; d < 4; ++d) o[d][r] *= a; } }
            const int vb = vb0 + buf * SHM_V;
            pv_one<0>(o[0], vb, pa0, pa1, pa2, pa3); pv_one<1>(o[1], vb, pa0, pa1, pa2, pa3); pv_one<2>(o[2], vb, pa0, pa1, pa2, pa3); pv_one<3>(o[3], vb, pa0, pa1, pa2, pa3);
        }
        asm volatile("s_waitcnt vmcnt(0)" ::: "memory");
        __syncthreads();
    }
#undef STAGE_T
#undef GLDS
    if (nact > 0) {
        if (hi == 0) li_l[r32] = l_reg; asm volatile("s_waitcnt lgkmcnt(0)" ::: "memory");
#pragma unroll
        for (int r = 0; r < 16; ++r) { const int orow = crow(r, hi); if (orow < orows) { const float rl = __builtin_amdgcn_rcpf(li_l[orow]);
#pragma unroll
            for (int d0 = 0; d0 < 4; ++d0) Orow0[(size_t)orow * 1024 + d0 * 32 + r32] = f2bf(o[d0][r] * rl); } }
    }
}
__device__ void attn_phase(const Params& P, unsigned char* lds) {
    unsigned char* ws = P.ws; const int tid = threadIdx.x, wid = tid >> 6, lane = tid & 63, r32 = lane & 31;
    const bf16_t* QB = (const bf16_t*)(ws + WS_QB); const bf16_t* KVB = (const bf16_t*)(ws + WS_KVB); const bf16_t* KPE = (const bf16_t*)(ws + WS_KPE); bf16_t* CAT = (bf16_t*)(ws + WS_CAT); const float* RT = (const float*)(ws + WS_ROPE);
    for (int pr = blockIdx.x; pr < 512; pr += gridDim.x) {
        const int c = pr & 255, rnd = pr >> 8, xcd = c & 7, slot = c >> 3, bh = rnd * 16 + xcd * 2 + (slot >> 4), x = slot & 15, b = bh >> 2, h = bh & 3;
#pragma unroll 1
        for (int s = 0; s < 2; ++s) { const int qb = s == 0 ? 31 - x : x; const int q0 = b * 8192 + qb * 256 + wid * 32;
            attn_unit(QB + (size_t)(q0 + r32) * 768 + h * 192, RT + (size_t)((q0 + r32) & 8191) * 64, KVB + (size_t)(b * 8192) * 1024 + h * 128, KPE + (size_t)(b * 8192) * 64,
                      CAT + (size_t)q0 * 1024 + 512 + h * 128, 32, 4 * qb + 4, 4 * qb + 1 + (wid >> 1), 64, lds); }
    }
    for (int su = blockIdx.x; su < 32; su += gridDim.x) { const int b = su >> 2, h = su & 3; const int q0 = TP + b * 16;
        attn_unit(QB + (size_t)(q0 + (r32 & 15)) * 768 + h * 192, RT + (size_t)(2048 + (r32 & 15)) * 64, KVB + (size_t)(TP + b * KVS) * 1024 + h * 128, KPE + (size_t)(TP + b * KVS) * 64,
                  CAT + (size_t)q0 * 1024 + 512 + h * 128, 16, 33, wid == 0 ? 33 : 0, 16, lds); }
}
}

__device__ void ln1_phase(const Params& P) {
    unsigned char* ws = P.ws; const int lane = threadIdx.x & 63; const int gw = blockIdx.x * 8 + (threadIdx.x >> 6), nw = gridDim.x * 8;
    const bf16_t* R1 = (const bf16_t*)(ws + WS_R1); bf16_t* H = (bf16_t*)(ws + WS_H); const float* g = P.in[16]; const float* bb = P.in[17];
    float gg[16], bv[16];
#pragma unroll
    for (int e = 0; e < 8; ++e) { gg[e] = g[lane * 8 + e]; gg[8 + e] = g[512 + lane * 8 + e]; bv[e] = bb[lane * 8 + e]; bv[8 + e] = bb[512 + lane * 8 + e]; }
    for (int t = gw; t < TOK; t += nw) {
        const u32x4 w0 = *(const u32x4*)(R1 + (size_t)t * 1024 + lane * 8), w1 = *(const u32x4*)(R1 + (size_t)t * 1024 + 512 + lane * 8);
        float x[16] = {blo(w0.x), bhi(w0.x), blo(w0.y), bhi(w0.y), blo(w0.z), bhi(w0.z), blo(w0.w), bhi(w0.w), blo(w1.x), bhi(w1.x), blo(w1.y), bhi(w1.y), blo(w1.z), bhi(w1.z), blo(w1.w), bhi(w1.w)};
        float s = 0.f;
#pragma unroll
        for (int e = 0; e < 16; ++e) s += x[e];
        const float mu = wsum(s) * (1.f / 1024.f); float q = 0.f;
#pragma unroll
        for (int e = 0; e < 16; ++e) { x[e] -= mu; q += x[e] * x[e]; }
        const float rstd = rsqrtf(wsum(q) * (1.f / 1024.f) + 1e-5f);
#pragma unroll
        for (int e = 0; e < 16; ++e) x[e] = x[e] * rstd * gg[e] + bv[e];
        u32x4 o0, o1; o0.x = cvt_pk_bf16(x[0], x[1]); o0.y = cvt_pk_bf16(x[2], x[3]); o0.z = cvt_pk_bf16(x[4], x[5]); o0.w = cvt_pk_bf16(x[6], x[7]);
        o1.x = cvt_pk_bf16(x[8], x[9]); o1.y = cvt_pk_bf16(x[10], x[11]); o1.z = cvt_pk_bf16(x[12], x[13]); o1.w = cvt_pk_bf16(x[14], x[15]);
        *(u32x4*)(H + (size_t)t * 1024 + lane * 8) = o0; *(u32x4*)(H + (size_t)t * 1024 + 512 + lane * 8) = o1;
    }
}
__device__ void ln2_phase(const Params& P) {
    const int lane = threadIdx.x & 63; const int gw = blockIdx.x * 8 + (threadIdx.x >> 6), nw = gridDim.x * 8;
    float* Y = P.out + O_YP; const float* g = P.in[22]; const float* bb = P.in[23];
    f32x4 gg[4], bv[4];
#pragma unroll
    for (int i = 0; i < 4; ++i) { gg[i] = *(const f32x4*)(g + i * 256 + lane * 4); bv[i] = *(const f32x4*)(bb + i * 256 + lane * 4); }
    for (int t = gw; t < TOK; t += nw) {
        float* yr = Y + (size_t)t * 1024; f32x4 x[4]; float s = 0.f;
#pragma unroll
        for (int i = 0; i < 4; ++i) { x[i] = *(const f32x4*)(yr + i * 256 + lane * 4); s += (x[i][0] + x[i][1]) + (x[i][2] + x[i][3]); }
        const float mu = wsum(s) * (1.f / 1024.f); float q = 0.f;
#pragma unroll
        for (int i = 0; i < 4; ++i) { x[i] = x[i] - mu; q += (x[i][0] * x[i][0] + x[i][1] * x[i][1]) + (x[i][2] * x[i][2] + x[i][3] * x[i][3]); }
        const float rstd = rsqrtf(wsum(q) * (1.f / 1024.f) + 1e-5f);
#pragma unroll
        for (int i = 0; i < 4; ++i) *(f32x4*)(yr + i * 256 + lane * 4) = x[i] * rstd * gg[i] + bv[i];
    }
}
__device__ __forceinline__ void ld8bf(const bf16_t* p, float* x) { const u32x4 w = *(const u32x4*)p; x[0] = blo(w.x); x[1] = bhi(w.x); x[2] = blo(w.y); x[3] = bhi(w.y); x[4] = blo(w.z); x[5] = bhi(w.z); x[6] = blo(w.w); x[7] = bhi(w.w); }
__device__ __forceinline__ void ld8f(const float* p, float* x) { const f32x4 a = *(const f32x4*)p, b = *(const f32x4*)(p + 4); x[0] = a[0]; x[1] = a[1]; x[2] = a[2]; x[3] = a[3]; x[4] = b[0]; x[5] = b[1]; x[6] = b[2]; x[7] = b[3]; }
__device__ void ffn_fix_phase(const Params& P) {
    unsigned char* ws = P.ws; const long gtid = blockIdx.x * 512L + threadIdx.x, gsz = gridDim.x * 512L;
    const bf16_t* BND = (const bf16_t*)(ws + WS_BND); const bf16_t* UPS = (const bf16_t*)(ws + WS_UPS); bf16_t* ACT = (bf16_t*)(ws + WS_ACT);
    const float* wc = P.in[19]; const float* bc = P.in[20]; const float* st = P.in[4];
    const long n_p = 1024L * 2 * 352, n_s = 128L * 352;
    for (long it = gtid; it < n_p + n_s; it += gsz) {
        const bool samp = it >= n_p; const long q = samp ? it - n_p : it;
        const int f = (int)(q % 352) * 8; const int rr = (int)(q / 352);
        int t; float res[2][8];
#pragma unroll
        for (int part = 0; part < 2; ++part) { const int col = f + part * DFF; float x2[8], x1[8], x0[8];
            if (!samp) { const int s_ = rr >> 1, r = rr & 1; t = s_ * 64 + r; const bool first = (s_ & 127) == 0;
                const bf16_t* B = BND + (size_t)s_ * 4 * DFF2 + col;
                ld8bf(B + (size_t)r * DFF2, x2);
                if (r == 1) ld8bf(B, x1); else if (!first) ld8bf(B - (size_t)1 * DFF2, x1); else {
#pragma unroll
                    for (int e = 0; e < 8; ++e) x1[e] = 0.f; }
                if (!first) ld8bf(B - (size_t)(r == 1 ? 1 : 2) * DFF2, x0); else {
#pragma unroll
                    for (int e = 0; e < 8; ++e) x0[e] = 0.f; }
            } else { const int pos = rr & 15, sb = rr >> 4; t = TP + rr;
                ld8bf(UPS + (size_t)rr * DFF2 + col, x2);
                if (pos >= 1) ld8bf(UPS + (size_t)(rr - 1) * DFF2 + col, x1); else ld8f(st + ((size_t)sb * 2 + 1) * DFF2 + col, x1);
                if (pos >= 2) ld8bf(UPS + (size_t)(rr - 2) * DFF2 + col, x0); else ld8f(st + ((size_t)sb * 2 + pos) * DFF2 + col, x0);
            }
            float w2[8], w1[8], w0[8], bb[8]; ld8f(wc + 2 * DFF2 + col, w2); ld8f(wc + DFF2 + col, w1); ld8f(wc + col, w0); ld8f(bc + col, bb);
#pragma unroll
            for (int e = 0; e < 8; ++e) res[part][e] = bb[e] + w2[e] * x2[e] + w1[e] * x1[e] + w0[e] * x0[e];
        }
        u32x4 o;
        o.x = cvt_pk_bf16(silu(res[0][0]) * res[1][0], silu(res[0][1]) * res[1][1]); o.y = cvt_pk_bf16(silu(res[0][2]) * res[1][2], silu(res[0][3]) * res[1][3]);
        o.z = cvt_pk_bf16(silu(res[0][4]) * res[1][4], silu(res[0][5]) * res[1][5]); o.w = cvt_pk_bf16(silu(res[0][6]) * res[1][6], silu(res[0][7]) * res[1][7]);
        *(u32x4*)(ACT + (size_t)t * DFF + f) = o;
    }
    for (long it = gtid; it < 2L * 16 * DFF2; it += gsz) { const int col = (int)(it % DFF2); const int rj = (int)(it / DFF2); const bool samp = rj >= 16; const int b = (rj & 15) >> 1, j = rj & 1;
        if (!samp) P.out[O_FCP + ((size_t)b * 2 + j) * DFF2 + col] = bf2f(BND[((size_t)(b * 128 + 127) * 4 + 2 + j) * DFF2 + col]);
        else P.out[O_FCS + ((size_t)b * 2 + j) * DFF2 + col] = bf2f(UPS[(size_t)(b * 16 + 14 + j) * DFF2 + col]); }
}

#define XB_TMO      128
#define XB_XCNT(j)  (256  + 64 * (j))
#define XB_XSUB(j)  (1280 + 64 * (j))
#define XB_XGEN(j)  (2304 + 64 * (j))
#define XB_TOP      3328
#define XB_TOPGEN   3392
#define XCD_BAR_WORDS 3456
#define XB_SPIN_CAP (1u << 18)
#define LAS PG8_LAS

__device__ __forceinline__ unsigned xb_ld(unsigned* p)              { return __hip_atomic_load(p, __ATOMIC_RELAXED, __HIP_MEMORY_SCOPE_AGENT); }
__device__ __forceinline__ unsigned xb_add(unsigned* p, unsigned v) { return __hip_atomic_fetch_add(p, v, __ATOMIC_RELAXED, __HIP_MEMORY_SCOPE_AGENT); }
__device__ __forceinline__ unsigned xb_xcc_id() { return (unsigned)__builtin_amdgcn_s_getreg((3 << 11) | 20) & 0xFu; }
#define XB_SPIN(cond, bar) do { unsigned _sp = 0; while (cond) { __builtin_amdgcn_s_sleep(1); \
    if ((++_sp & 255u) == 0u) { if (xb_ld(&(bar)[XB_TMO])) break; if (_sp > XB_SPIN_CAP) { atomicAdd(&(bar)[XB_TMO], 1u); break; } } } } while (0)

struct XcdBarrier {
    unsigned* bar; unsigned x;
    volatile LAS unsigned* st;
};

__device__ __forceinline__ XcdBarrier xcd_barrier_post(unsigned* bar, volatile LAS unsigned* st) {
    XcdBarrier b; b.bar = bar; b.x = xb_xcc_id(); b.st = st;
    if (threadIdx.x == 0) (void)xb_add(&bar[XB_XCNT(b.x)], 1u);
    return b;
}
__device__ __forceinline__ void xcd_barrier_complete(unsigned* bar, unsigned x, unsigned& nloc, unsigned& nx) {
    const unsigned G = gridDim.x * gridDim.y * gridDim.z;
    unsigned sum, cnt, mine, sp = 0u;
    for (;;) {
        sum = 0u; cnt = 0u; mine = 0u;
#pragma unroll
        for (unsigned j = 0; j < 16; ++j) { const unsigned c = xb_ld(&bar[XB_XCNT(j)]); sum += c; cnt += (c > 0u) ? 1u : 0u; mine = (j == x) ? c : mine; }
        if (sum == G) break;
        __builtin_amdgcn_s_sleep(1);
        if ((++sp & 255u) == 0u) { if (xb_ld(&bar[XB_TMO])) break; if (sp > XB_SPIN_CAP) { atomicAdd(&bar[XB_TMO], 1u); break; } }
    }
    nloc = mine > 0u ? mine : 1u; nx = cnt > 0u ? cnt : 1u;
}

__device__ __forceinline__ void xcd_barrier(const XcdBarrier& b) {
    asm volatile("s_waitcnt vmcnt(0)" ::: "memory");
    __syncthreads();
    if (threadIdx.x == 0) {
        unsigned* bar = b.bar;
        __builtin_amdgcn_s_waitcnt(0);
        unsigned nloc = b.st[0], nx = b.st[1];
        if (nloc == 0u) { xcd_barrier_complete(bar, b.x, nloc, nx); b.st[0] = nloc; b.st[1] = nx; }
        const unsigned old = xb_add(&bar[XB_XSUB(b.x)], 1u);
        const unsigned gen = old / nloc;
        if (old + 1u == (gen + 1u) * nloc) {
            __builtin_amdgcn_fence(__ATOMIC_RELEASE, "agent");
            asm volatile("s_waitcnt vmcnt(0)" ::: "memory");
            const unsigned og = xb_add(&bar[XB_TOP], 1u);
            const unsigned tg = og / nx;
            if (og + 1u == (tg + 1u) * nx) xb_add(&bar[XB_TOPGEN], 1u);
            else XB_SPIN(xb_ld(&bar[XB_TOPGEN]) == tg, bar);
            __builtin_amdgcn_fence(__ATOMIC_ACQUIRE, "agent");
            xb_add(&bar[XB_XGEN(b.x)], 1u);
            asm volatile("s_waitcnt vmcnt(0)" ::: "memory");
        } else {
            XB_SPIN(xb_ld(&bar[XB_XGEN(b.x)]) == gen, bar);
            __builtin_amdgcn_fence(__ATOMIC_ACQUIRE, "agent");
            asm volatile("s_waitcnt vmcnt(0)" ::: "memory");
        }
    }
    __syncthreads();
}

constexpr int NPHASE = 11;
__global__ void __launch_bounds__(512, 2) mega_fwd(Params P) {
    extern __shared__ __attribute__((aligned(16))) unsigned char lds[];
    cg::grid_group grid = cg::this_grid();
    PG8_LAS unsigned char* ldsl = (PG8_LAS unsigned char*)lds;
    unsigned char* ws = P.ws; const int lo = P.ph_lo, hi = P.ph_hi; const int G = gridDim.x, bx = blockIdx.x;
#ifndef PHMASK
#define PHMASK 0xFFFF
#endif
#define IN(k) (((PHMASK >> (k)) & 1) && lo <= (k) && (k) < hi)
    volatile PG8_LAS unsigned* xst = (volatile PG8_LAS unsigned*)(ldsl + LDS_BYTES);
    if (threadIdx.x < 4) xst[threadIdx.x] = 0u;
    __syncthreads();
    XcdBarrier xb = xcd_barrier_post((unsigned*)(ws + WS_BAR), xst);
#define SEAM(k) do { if (IN(k) && IN((k) + 1)) { if ((k) == 0) grid.sync(); else xcd_barrier(xb); } } while (0)
    if (IN(0)) p0_prologue(P, lds);
    SEAM(0);
    if (IN(1)) { pg8::Gemm g{(const bf16_t*)(ws + WS_XB), (const bf16_t*)(ws + WS_WIN), TOKP, NIN, 1024}; pg8::StaticOrder S; S.init(TOKP, NIN, G, bx);
        pg8::EpiPlain E{(bf16_t*)(ws + WS_PROJ), NIN, 4, 1.f}; pg8::gemm_phase<pg8::EpiPlain, pg8::StaticOrder, true, true>(ldsl, g, S, E); }
    SEAM(1);
    if (IN(2)) p2_token(P);
    SEAM(2);
    if (IN(3)) {
#ifndef NOQ
        { pg8::Gemm g{(const bf16_t*)(ws + WS_CQN), (const bf16_t*)(ws + WS_WUQ), TOKP, 768, 384}; pg8::StaticOrder S; S.init(TOKP, 768, G, bx);
          pg8::EpiPlain E{(bf16_t*)(ws + WS_QB), 768, 0, QSCALE}; pg8::gemm_phase<pg8::EpiPlain, pg8::StaticOrder, true, true>(ldsl, g, S, E); }
#endif
#ifndef NOKV
        { pg8::Gemm g{(const bf16_t*)(ws + WS_CKVN), (const bf16_t*)(ws + WS_WKV), KVRP, 1024, 256}; pg8::StaticOrder S; S.init(KVRP, 1024, G, bx);
          pg8::EpiPlain E{(bf16_t*)(ws + WS_KVB), 1024, 0, 1.f}; pg8::gemm_phase<pg8::EpiPlain, pg8::StaticOrder, true, true>(ldsl, g, S, E); }
#endif
#ifndef NOSP
        spatial_phase(P, lds);
#endif
    }
    SEAM(3);
    if (IN(4)) att::attn_phase(P, lds);
    SEAM(4);
    if (IN(5)) { pg8::Gemm g{(const bf16_t*)(ws + WS_CAT), (const bf16_t*)(ws + WS_WO), TOKP, 1024, 1024}; pg8::StaticOrder S; S.init(TOKP, 1024, G, bx);
        pg8::EpiWo E{(bf16_t*)(ws + WS_R1), P.in[0], P.in[1]}; pg8::gemm_phase<pg8::EpiWo, pg8::StaticOrder, true, true>(ldsl, g, S, E); }
    SEAM(5);
    if (IN(6)) ln1_phase(P);
    SEAM(6);
    if (IN(7)) { pg8::Gemm g{(const bf16_t*)(ws + WS_H), (const bf16_t*)(ws + WS_WUP), TOKP, DFF2, 1024}; pg8::StaticOrder S; S.init(TOKP, DFF2, G, bx);
        pg8::EpiUpConv E{(bf16_t*)(ws + WS_ACT), (bf16_t*)(ws + WS_BND), (bf16_t*)(ws + WS_UPS), P.in[19], P.in[20]}; pg8::gemm_phase<pg8::EpiUpConv, pg8::StaticOrder, true, true>(ldsl, g, S, E); }
    SEAM(7);
    if (IN(8)) ffn_fix_phase(P);
    SEAM(8);
    if (IN(9)) { pg8::Gemm g{(const bf16_t*)(ws + WS_ACT), (const bf16_t*)(ws + WS_WDN), TOKP, 1024, DFF}; pg8::StaticOrder S; S.init(TOKP, 1024, G, bx);
        pg8::EpiDown E{P.out + O_YP, (const bf16_t*)(ws + WS_H)}; pg8::gemm_phase<pg8::EpiDown, pg8::StaticOrder, true, true>(ldsl, g, S, E); }
    SEAM(9);
    if (IN(10)) ln2_phase(P);
#undef IN
#undef SEAM
}

extern "C" void kernel_launch(void* const* d_in, const int* in_sizes, int n_in, void* d_out, int out_size, void* d_ws, size_t ws_size, hipStream_t stream) {
    static int grid_blocks = 0;
    if (grid_blocks == 0) {
        if (n_in != 24 || out_size != (int)O_END || ws_size < WS_TOTAL) { fprintf(stderr, "kernel_launch: unexpected shapes: n_in %d out %d ws %zu (need %zu)\n", n_in, out_size, ws_size, (size_t)WS_TOTAL); grid_blocks = -1; return; }
        int dev = 0, cus = 0, per_cu = 0;
        hipGetDevice(&dev); hipDeviceGetAttribute(&cus, hipDeviceAttributeMultiprocessorCount, dev);
        if (hipFuncSetAttribute((const void*)mega_fwd, hipFuncAttributeMaxDynamicSharedMemorySize, LDS_BYTES + 256) != hipSuccess) { fprintf(stderr, "kernel_launch: hipFuncSetAttribute failed\n"); grid_blocks = -1; return; }
        if (hipOccupancyMaxActiveBlocksPerMultiprocessor(&per_cu, (const void*)mega_fwd, 512, LDS_BYTES + 256) != hipSuccess || per_cu < 1) { fprintf(stderr, "kernel_launch: occupancy query gave %d\n", per_cu); per_cu = 1; }
        (void)hipGetLastError();
        grid_blocks = cus * 1;
    }
    if (grid_blocks < 0) return;
    if (hipMemsetAsync((char*)d_ws + WS_BAR, 0, 16384, stream) != hipSuccess) { fprintf(stderr, "kernel_launch: memset failed\n"); return; }
    Params p{};
    for (int i = 0; i < 24; ++i) p.in[i] = (const float*)d_in[i];
    p.out = (float*)d_out; p.ws = (unsigned char*)d_ws;
#if defined(MK_MULTI)
    for (int ph = 0; ph < NPHASE; ++ph) { p.ph_lo = ph; p.ph_hi = ph + 1; hipLaunchKernelGGL(mega_fwd, dim3(grid_blocks), dim3(512), LDS_BYTES + 256, stream, p); }
#else
    p.ph_lo = 0; p.ph_hi = NPHASE;
    void* args[] = {&p};
    hipError_t e = hipLaunchCooperativeKernel((const void*)mega_fwd, dim3(grid_blocks), dim3(512), args, LDS_BYTES + 256, stream);
    if (e != hipSuccess) fprintf(stderr, "kernel_launch: cooperative launch failed: %s (grid %d)\n", hipGetErrorString(e), grid_blocks);
#endif
}
```

```cpp
#include <hip/hip_runtime.h>
#include <hip/hip_cooperative_groups.h>
#include <cstdio>
#include <cstdint>
namespace cg = cooperative_groups;
namespace pg8 {
#define PG8_LAS __attribute__((address_space(3)))
typedef unsigned short bf16_t;
typedef short bf16x8 __attribute__((ext_vector_type(8)));
typedef float f32x4 __attribute__((ext_vector_type(4)));
typedef unsigned u32x4 __attribute__((ext_vector_type(4)));
constexpr int BM = 256, BK = 64, HALF = 128, HTB = HALF * BK * 2  , STAGE_BYTES = 8 * HTB, NXCD = 8, WGM = 8;

__host__ __device__ __forceinline__ int lds_byte(int r, int c) { const int st = (r >> 4) * 2 + (c >> 5), rr = r & 15, cc = c & 31, ob = rr * 64 + cc * 2; return st * 1024 + (ob ^ (((ob >> 9) & 1) << 5)); }
__host__ __device__ __forceinline__ void stage_rc(int b, int& R, int& C) { const int st = b / 1024, sb = b % 1024, swz = sb ^ (((sb >> 9) & 1) << 5); R = (st >> 1) * 16 + swz / 64; C = (st & 1) * 32 + (swz % 64) / 2; }
__host__ __device__ __forceinline__ int perm32(int rho) { const int n = rho >> 4, i = rho & 15; return 8 * (i >> 2) + 4 * n + (i & 3); }

struct Unit { int pm, pn; };
struct Gemm { const bf16_t* A; const bf16_t* Bt; int M, N, K; };

struct StaticOrder {
    int nM, nN, nwg, G, c;
    __host__ __device__ void init(int M, int N, int G_, int c_) { nM = M / BM; nN = N / BM; nwg = nM * nN; G = G_; c = c_; }
    __host__ __device__ bool next(int i, Unit& u) const {
        const long L = (long)i * G + c; if (L >= nwg) return false;
        int wgid = (int)L; { const int q = nwg / NXCD, r = nwg % NXCD, xcd = wgid % NXCD, off = wgid / NXCD; wgid = (xcd < r ? xcd * (q + 1) : r * (q + 1) + (xcd - r) * q) + off; }
        const int nig = WGM * nN, gid = wgid / nig, fm = gid * WGM, gsz = (nM - fm) < WGM ? (nM - fm) : WGM;
        u.pm = fm + ((wgid % nig) % gsz); u.pn = (wgid % nig) / gsz; return true;
    }
    __device__ __forceinline__ void a_ready(const Unit&) const {}
    __device__ __forceinline__ void done(const Unit&) const {}
};

__device__ __forceinline__ unsigned cvt_pk_bf16(float lo, float hi) { unsigned r; asm volatile("v_cvt_pk_bf16_f32 %0, %1, %2" : "=v"(r) : "v"(lo), "v"(hi)); return r; }
typedef float f32x2 __attribute__((ext_vector_type(2)));
template <class Epi, class Sched, bool ALIGN_EPI = false, bool SP2 = false>
__device__ __forceinline__ void gemm_phase(PG8_LAS unsigned char* lds, const Gemm g, const Sched& S, const Epi& E) {
    const int tid = threadIdx.x, wid = __builtin_amdgcn_readfirstlane(tid >> 6), lane = tid & 63, wr = wid >> 2, wc = wid & 3, fr = lane & 15, fq = lane >> 4;
    const int K = g.K, nt = K / BK;
    unsigned voffA[2], voffB[2];
#pragma unroll
    for (int i = 0; i < 2; ++i) { int R, C; stage_rc(tid * 16 + i * 8192, R, C); const int Rb = Epi::PERM ? ((R & ~31) + perm32(R & 31)) : R;
        voffA[i] = (unsigned)(R * K + C) * 2u; voffB[i] = (unsigned)(Rb * K + C) * 2u; }
    const size_t kstep = (size_t)(BK * 2);
    const size_t hstep = (size_t)HALF * K * 2;
    const size_t tstep = 2 * hstep;
    const unsigned ldsw = (unsigned)wid * 1024u;
    const int aoff = lds_byte(wr * 64 + fr, fq * 8), boff = lds_byte(wc * 32 + fr, fq * 8);
#define PG8_SA(b, h) (((b) * 2 + (h)) * HTB)
#define PG8_SB(b, h) ((4 + (b) * 2 + (h)) * HTB)
#define PG8_STAGE(bufoff, gbase, voff) do { _Pragma("unroll") for (int _i = 0; _i < 2; ++_i) \
        __builtin_amdgcn_global_load_lds((const unsigned*)((const char*)(gbase) + (voff)[_i]), (PG8_LAS unsigned*)(lds + (bufoff) + ldsw + _i * 8192), 16, 0, 0); } while (0)
#define PG8_LDA(dst, b, h) do { _Pragma("unroll") for (int m = 0; m < 4; ++m) _Pragma("unroll") for (int k = 0; k < 2; ++k) dst[m][k] = *(const PG8_LAS bf16x8*)(lds + PG8_SA(b, h) + aoff + m * 2048 + k * 1024); } while (0)
#define PG8_LDB(dst, b, h) do { _Pragma("unroll") for (int n = 0; n < 2; ++n) _Pragma("unroll") for (int k = 0; k < 2; ++k) dst[n][k] = *(const PG8_LAS bf16x8*)(lds + PG8_SB(b, h) + boff + n * 2048 + k * 1024); } while (0)
#define PG8_MMA(ai, bj, At, Bt) do { __builtin_amdgcn_s_setprio(1); _Pragma("unroll") for (int m = 0; m < 4; ++m) _Pragma("unroll") for (int n = 0; n < 2; ++n) _Pragma("unroll") for (int k = 0; k < 2; ++k) \
        acc[ai][bj][m][n] = __builtin_amdgcn_mfma_f32_16x16x32_bf16(Bt[n][k], At[m][k], acc[ai][bj][m][n], 0, 0, 0); __builtin_amdgcn_s_setprio(0); } while (0)
#define PG8_WAIT_V(n) asm volatile("s_waitcnt vmcnt(" #n ")" ::: "memory")
#define PG8_WAIT_L(n) asm volatile("s_waitcnt lgkmcnt(" #n ")" ::: "memory")
#define PG8_BAR __builtin_amdgcn_s_barrier()
#define PG8_SCHED __builtin_amdgcn_sched_barrier(0)
    Unit cur, nxt; int ui = 0;
    if (!S.next(0, cur)) return;
    f32x4 acc[2][2][4][2];
#pragma unroll
    for (int a = 0; a < 2; ++a)
#pragma unroll
        for (int b = 0; b < 2; ++b)
#pragma unroll
            for (int m = 0; m < 4; ++m)
#pragma unroll
                for (int n = 0; n < 2; ++n) acc[a][b][m][n] = (f32x4){0.f, 0.f, 0.f, 0.f};
    bf16x8 At[4][2], B0[2][2], B1[2][2];
    const char* cA = (const char*)g.A + (size_t)cur.pm * tstep; const char* cB = (const char*)g.Bt + (size_t)cur.pn * tstep;
    S.a_ready(cur);
    if constexpr (SP2) {
        PG8_STAGE(PG8_SB(0, 0), cB, voffB); PG8_STAGE(PG8_SB(0, 1), cB + hstep, voffB); PG8_STAGE(PG8_SA(0, 0), cA, voffA); PG8_STAGE(PG8_SA(0, 1), cA + hstep, voffA);
        if (wr == 1) PG8_BAR;
        PG8_WAIT_V(2); PG8_BAR;
        PG8_STAGE(PG8_SB(1, 0), cB + kstep, voffB); PG8_STAGE(PG8_SA(1, 0), cA + kstep, voffA); PG8_STAGE(PG8_SB(1, 1), cB + hstep + kstep, voffB);
        PG8_WAIT_V(6); PG8_BAR;
    } else {
        PG8_STAGE(PG8_SB(0, 0), cB, voffB); PG8_STAGE(PG8_SA(0, 0), cA, voffA); PG8_STAGE(PG8_SB(0, 1), cB + hstep, voffB); PG8_STAGE(PG8_SA(0, 1), cA + hstep, voffA);
        if (wr == 1) PG8_BAR;
        PG8_WAIT_V(4); PG8_BAR;
        PG8_STAGE(PG8_SB(1, 0), cB + kstep, voffB); PG8_STAGE(PG8_SA(1, 0), cA + kstep, voffA); PG8_STAGE(PG8_SB(1, 1), cB + hstep + kstep, voffB);
        PG8_WAIT_V(6); PG8_BAR;
    }
    for (;;) {
        const bool has_next = S.next(ui + 1, nxt);
        const bool halfu = (cur.pm == g.M / BM - 1);
        const char* nA = has_next ? (const char*)g.A + (size_t)nxt.pm * tstep : cA; const char* nB = has_next ? (const char*)g.Bt + (size_t)nxt.pn * tstep : cB;
        for (int t = 0; t < nt; t += 2) {
            const bool last = (t == nt - 2);
            const char* a1 = cA + (size_t)(t + 1) * kstep;
            const char* a2 = last ? nA : cA + (size_t)(t + 2) * kstep; const char* b2 = last ? nB : cB + (size_t)(t + 2) * kstep;
            const char* a3 = a2 + kstep; const char* b3 = b2 + kstep;
            if (last && has_next) S.a_ready(nxt);
            if constexpr (SP2) {
            PG8_LDB(B0, 0, 0); PG8_LDB(B1, 0, 1); PG8_SCHED; PG8_LDA(At, 0, 0); PG8_STAGE(PG8_SA(1, 1), a1 + hstep, voffA);
            PG8_WAIT_V(8); PG8_WAIT_L(0); PG8_BAR; PG8_MMA(0, 0, At, B0); PG8_MMA(0, 1, At, B1); PG8_BAR; PG8_SCHED;
            PG8_LDA(At, 0, 1); PG8_STAGE(PG8_SB(0, 0), b2, voffB); PG8_STAGE(PG8_SB(0, 1), b2 + hstep, voffB); PG8_STAGE(PG8_SA(0, 0), a2, voffA);
            PG8_WAIT_V(8); PG8_WAIT_L(0); PG8_BAR; if (!halfu) { PG8_MMA(1, 0, At, B0); PG8_MMA(1, 1, At, B1); } PG8_BAR; PG8_SCHED;
            PG8_LDB(B0, 1, 0); PG8_LDB(B1, 1, 1); PG8_SCHED; PG8_LDA(At, 1, 0); PG8_STAGE(PG8_SA(0, 1), a2 + hstep, voffA);
            PG8_WAIT_V(8); PG8_WAIT_L(0); PG8_BAR; PG8_MMA(0, 0, At, B0); PG8_MMA(0, 1, At, B1); PG8_BAR; PG8_SCHED;
            PG8_LDA(At, 1, 1); PG8_STAGE(PG8_SB(1, 0), b3, voffB); PG8_STAGE(PG8_SB(1, 1), b3 + hstep, voffB); PG8_STAGE(PG8_SA(1, 0), a3, voffA);
            PG8_WAIT_V(8); PG8_WAIT_L(0); PG8_BAR; if (!halfu) { PG8_MMA(1, 0, At, B0); PG8_MMA(1, 1, At, B1); } PG8_BAR; PG8_SCHED;
            } else {
            PG8_LDB(B0, 0, 0); PG8_SCHED; PG8_LDA(At, 0, 0); PG8_STAGE(PG8_SA(1, 1), a1 + hstep, voffA);
            PG8_WAIT_L(8); PG8_BAR; PG8_WAIT_L(0); PG8_MMA(0, 0, At, B0); PG8_BAR; PG8_SCHED;
            PG8_LDB(B1, 0, 1); PG8_STAGE(PG8_SB(0, 0), b2, voffB);
            PG8_BAR; PG8_WAIT_L(0); PG8_MMA(0, 1, At, B1); PG8_BAR;
            PG8_LDA(At, 0, 1); PG8_STAGE(PG8_SA(0, 0), a2, voffA);
            PG8_BAR; PG8_WAIT_L(0); PG8_MMA(1, 0, At, B0); PG8_BAR; PG8_SCHED;
            PG8_STAGE(PG8_SB(0, 1), b2 + hstep, voffB);
            PG8_WAIT_V(6); PG8_BAR; PG8_MMA(1, 1, At, B1); PG8_BAR;
            PG8_LDB(B0, 1, 0); PG8_SCHED; PG8_LDA(At, 1, 0); PG8_STAGE(PG8_SA(0, 1), a2 + hstep, voffA);
            PG8_WAIT_L(8); PG8_BAR; PG8_WAIT_L(0); PG8_MMA(0, 0, At, B0); PG8_BAR; PG8_SCHED;
            PG8_LDB(B1, 1, 1); PG8_STAGE(PG8_SB(1, 0), b3, voffB);
            PG8_BAR; PG8_WAIT_L(0); PG8_MMA(0, 1, At, B1); PG8_BAR;
            PG8_LDA(At, 1, 1); PG8_STAGE(PG8_SA(1, 0), a3, voffA);
            PG8_BAR; PG8_WAIT_L(0); PG8_MMA(1, 0, At, B0); PG8_BAR; PG8_SCHED;
            PG8_STAGE(PG8_SB(1, 1), b3 + hstep, voffB);
            PG8_WAIT_V(6); PG8_BAR; PG8_MMA(1, 1, At, B1); PG8_BAR;
            }
        }
        if constexpr (ALIGN_EPI) { if (wr == 0) PG8_BAR; }
        if constexpr (!Epi::AFTER_DRAIN) { E(acc, cur, wr, wc, fr, fq); S.done(cur); }
        if (!has_next) break;
#pragma unroll
        for (int a = 0; a < 2; ++a)
#pragma unroll
            for (int b = 0; b < 2; ++b)
#pragma unroll
                for (int m = 0; m < 4; ++m)
#pragma unroll
                    for (int n = 0; n < 2; ++n) acc[a][b][m][n] = (f32x4){0.f, 0.f, 0.f, 0.f};
        cur = nxt; cA = nA; cB = nB; ++ui;
        if constexpr (ALIGN_EPI) { if (wr == 1) PG8_BAR; }
    }
    PG8_WAIT_V(0);
    if constexpr (!ALIGN_EPI) { if (wr == 0) PG8_BAR; }
    PG8_BAR;
    if constexpr (Epi::AFTER_DRAIN) { E.fused(acc, cur, wr, wc, fr, fq, lds, wid, lane); S.done(cur); }
#undef PG8_SA
#undef PG8_SB
#undef PG8_STAGE
#undef PG8_LDA
#undef PG8_LDB
#undef PG8_MMA
#undef PG8_WAIT_V
#undef PG8_WAIT_L
#undef PG8_BAR
#undef PG8_SCHED
}
}

using pg8::bf16_t; using pg8::bf16x8; using pg8::f32x4; using pg8::u32x4; using pg8::cvt_pk_bf16;
typedef short s16x4 __attribute__((ext_vector_type(4)));
typedef float f32x16 __attribute__((ext_vector_type(16)));
constexpr int TP = 65536, TS = 128, TOK = TP + TS, TOKP = 65792;
constexpr int KVS = 2064, KVR = TP + 8 * KVS, KVRP = 82176;
constexpr int NIN = 1792, DFF = 2816, DFF2 = 5632;
constexpr float ALPHA = 1.189207115002721f;
constexpr float QSCALE = 0.07216878364870323f * 1.4426950408889634f;
constexpr long O_YP = 0, O_CKVP = 67239936L, O_KPEP = 84017152L, O_FCP = 88211456L, O_CKVS = 88301568L, O_KPES = 88334336L, O_GVS = 88342528L, O_FCS = 88408064L, O_END = 88498176L;
constexpr int LDS_BYTES = 131072;
constexpr size_t al256(size_t x) { return (x + 255) / 256 * 256; }
constexpr size_t WS_WIN = 0;
constexpr size_t WS_WUQ = WS_WIN + al256((size_t)NIN * 1024 * 2);
constexpr size_t WS_WKV = WS_WUQ + al256((size_t)768 * 384 * 2);
constexpr size_t WS_WO  = WS_WKV + al256((size_t)1024 * 256 * 2);
constexpr size_t WS_WUP = WS_WO + al256((size_t)1024 * 1024 * 2);
constexpr size_t WS_WDN = WS_WUP + al256((size_t)DFF2 * 1024 * 2);
constexpr size_t WS_WSP = WS_WDN + al256((size_t)1024 * DFF * 2);
constexpr size_t WS_WSS = WS_WSP + al256((size_t)4 * 128 * 128 * 2);
constexpr size_t WS_ROPE = WS_WSS + al256((size_t)4 * 128 * 128 * 2);
constexpr size_t WS_PROJ = WS_ROPE + al256((size_t)8192 * 32 * 8);
constexpr size_t WS_H = WS_PROJ;
constexpr size_t WS_XB = WS_PROJ + al256((size_t)TOKP * NIN * 2);
constexpr size_t WS_VN = WS_XB;
constexpr size_t WS_CQN = WS_VN + al256((size_t)TOKP * 512 * 2);
constexpr size_t WS_CKVN = WS_XB + al256((size_t)TOKP * 1024 * 2);
constexpr size_t WS_KPE = WS_CKVN + al256((size_t)KVRP * 256 * 2);
constexpr size_t WS_QB = WS_KPE + al256((size_t)KVRP * 64 * 2);
constexpr size_t WS_KVB = WS_QB + al256((size_t)TOKP * 768 * 2);
constexpr size_t WS_R1 = WS_KVB;
constexpr size_t WS_CAT = WS_KVB + al256((size_t)KVRP * 1024 * 2);
constexpr size_t WS_END = WS_CAT + al256((size_t)TOKP * 1024 * 2);
constexpr size_t WS_BAR = WS_END;
constexpr size_t WS_TOTAL = WS_BAR + 16384;
constexpr size_t WS_ACT = WS_XB;
constexpr size_t WS_BND = WS_ACT + al256((size_t)TOKP * DFF * 2);
constexpr size_t WS_UPS = WS_BND + al256((size_t)1024 * 4 * DFF2 * 2);
static_assert(WS_UPS + (size_t)128 * DFF2 * 2 <= WS_END, "FFN overlay does not fit");
static_assert(WS_CQN + (size_t)TOKP * 384 * 2 <= WS_CKVN, "VN+CQN overlay does not fit");

struct Params { const float* in[24]; float* out; unsigned char* ws; int ph_lo, ph_hi; };

__device__ __forceinline__ float bf2f(unsigned short h) { return __uint_as_float((unsigned)h << 16); }
__device__ __forceinline__ unsigned short f2bf(float f) { return (unsigned short)(cvt_pk_bf16(f, 0.f) & 0xffffu); }
__device__ __forceinline__ float blo(unsigned w) { return __uint_as_float(w << 16); }
__device__ __forceinline__ float bhi(unsigned w) { return __uint_as_float(w & 0xffff0000u); }
__device__ __forceinline__ float wsum(float v) {
#pragma unroll
    for (int o = 32; o > 0; o >>= 1) v += __shfl_xor(v, o);
    return v; }
__device__ __forceinline__ float gelu_tanh(float x) {
    const float u = 0.7978845608028654f * (x + 0.044715f * x * x * x);
    const float t = __builtin_amdgcn_exp2f(-2.885390081777927f * u);
    return x * __builtin_amdgcn_rcpf(1.f + t); }
__device__ __forceinline__ float silu(float x) { return x * __builtin_amdgcn_rcpf(1.f + __builtin_amdgcn_exp2f(-1.4426950408889634f * x)); }
__device__ __forceinline__ int rope_phys(int Ld) { const int nn = Ld >> 5, i = Ld & 31; return (i >> 4) * 32 + ((i & 15) >> 2) * 8 + nn * 4 + (i & 3); }
__device__ __forceinline__ int tok_pos(int row) { return row < TP ? (row & 8191) : (2048 + (row & 15)); }

namespace pg8 {
struct EpiPlain {
    static constexpr bool PERM = true, AFTER_DRAIN = false;
    bf16_t* O; int ldc; int gelu_tiles; float scale;
    __device__ __forceinline__ void operator()(const f32x4 (&acc)[2][2][4][2], const Unit& u, int wr, int wc, int fr, int fq) const {
        const int row0 = u.pm * BM + wr * 64 + fr, col0 = u.pn * BM + wc * 32 + 8 * fq; const bool g = u.pn < gelu_tiles;
#pragma unroll
        for (int ai = 0; ai < 2; ++ai)
#pragma unroll
            for (int m = 0; m < 4; ++m) { bf16_t* rowp = O + (size_t)(row0 + ai * HALF + m * 16) * ldc + col0;
#pragma unroll
                for (int bj = 0; bj < 2; ++bj) { f32x4 v0 = acc[ai][bj][m][0], v1 = acc[ai][bj][m][1];
                    if (g) {
#pragma unroll
                        for (int e = 0; e < 4; ++e) { v0[e] = gelu_tanh(v0[e]); v1[e] = gelu_tanh(v1[e]); } }
                    v0 = v0 * scale; v1 = v1 * scale;
                    u32x4 w; w.x = cvt_pk_bf16(v0[0], v0[1]); w.y = cvt_pk_bf16(v0[2], v0[3]); w.z = cvt_pk_bf16(v1[0], v1[1]); w.w = cvt_pk_bf16(v1[2], v1[3]);
                    *(u32x4*)(rowp + bj * HALF) = w; } }
    }
};
struct EpiQ {
    static constexpr bool PERM = true, AFTER_DRAIN = false;
    bf16_t* O; const float* rope;
    __device__ __forceinline__ void operator()(const f32x4 (&acc)[2][2][4][2], const Unit& u, int wr, int wc, int fr, int fq) const {
        const int row0 = u.pm * BM + wr * 64 + fr, col0 = u.pn * BM + wc * 32 + 8 * fq;
#pragma unroll
        for (int ai = 0; ai < 2; ++ai)
#pragma unroll
            for (int m = 0; m < 4; ++m) { const int row = row0 + ai * HALF + m * 16; bf16_t* rowp = O + (size_t)row * 768 + col0; const int pos = tok_pos(row);
#pragma unroll
                for (int bj = 0; bj < 2; ++bj) { f32x4 v0 = acc[ai][bj][m][0], v1 = acc[ai][bj][m][1];
                    const int within = (u.pn * BM + bj * HALF + wc * 32) % 192;
                    if (within >= 128) { const int i0 = ((within - 128) >> 5) * 16 + fq * 4; const float* rp = rope + ((size_t)pos * 32 + i0) * 2;
                        const f32x4 c01 = *(const f32x4*)rp, c23 = *(const f32x4*)(rp + 4);
                        const float cs[4] = {c01[0], c01[2], c23[0], c23[2]}, sn[4] = {c01[1], c01[3], c23[1], c23[3]};
#pragma unroll
                        for (int e = 0; e < 4; ++e) { const float x1 = v0[e], x2 = v1[e]; v0[e] = x1 * cs[e] - x2 * sn[e]; v1[e] = x2 * cs[e] + x1 * sn[e]; } }
                    v0 = v0 * QSCALE; v1 = v1 * QSCALE;
                    u32x4 w; w.x = cvt_pk_bf16(v0[0], v0[1]); w.y = cvt_pk_bf16(v0[2], v0[3]); w.z = cvt_pk_bf16(v1[0], v1[1]); w.w = cvt_pk_bf16(v1[2], v1[3]);
                    *(u32x4*)(rowp + bj * HALF) = w; }
                __builtin_amdgcn_sched_barrier(0); }
    }
};
struct EpiWo {
    static constexpr bool PERM = true, AFTER_DRAIN = false;
    bf16_t* O; const float* xp; const float* xs;
    __device__ __forceinline__ void operator()(const f32x4 (&acc)[2][2][4][2], const Unit& u, int wr, int wc, int fr, int fq) const {
        const int row0 = u.pm * BM + wr * 64 + fr, col0 = u.pn * BM + wc * 32 + 8 * fq;
#pragma unroll
        for (int ai = 0; ai < 2; ++ai)
#pragma unroll
            for (int m = 0; m < 4; ++m) { const int row = row0 + ai * HALF + m * 16; if (row >= TOK) continue;
                const float* xr = (row < TP ? xp + (size_t)row * 1024 : xs + (size_t)(row - TP) * 1024) + col0; bf16_t* rowp = O + (size_t)row * 1024 + col0;
#pragma unroll
                for (int bj = 0; bj < 2; ++bj) { const f32x4 a = *(const f32x4*)(xr + bj * HALF), b = *(const f32x4*)(xr + bj * HALF + 4);
                    const f32x4 v0 = acc[ai][bj][m][0] + a * ALPHA, v1 = acc[ai][bj][m][1] + b * ALPHA;
                    u32x4 w; w.x = cvt_pk_bf16(v0[0], v0[1]); w.y = cvt_pk_bf16(v0[2], v0[3]); w.z = cvt_pk_bf16(v1[0], v1[1]); w.w = cvt_pk_bf16(v1[2], v1[3]);
                    *(u32x4*)(rowp + bj * HALF) = w; } }
    }
};
struct EpiDown {
    static constexpr bool PERM = true, AFTER_DRAIN = false;
    float* Y; const bf16_t* H;
    __device__ __forceinline__ void operator()(const f32x4 (&acc)[2][2][4][2], const Unit& u, int wr, int wc, int fr, int fq) const {
        const int row0 = u.pm * BM + wr * 64 + fr, col0 = u.pn * BM + wc * 32 + 8 * fq;
#pragma unroll
        for (int ai = 0; ai < 2; ++ai)
#pragma unroll
            for (int m = 0; m < 4; ++m) { const int row = row0 + ai * HALF + m * 16; if (row >= TOK) continue;
                const bf16_t* hr = H + (size_t)row * 1024 + col0; float* yr = Y + (size_t)row * 1024 + col0;
#pragma unroll
                for (int bj = 0; bj < 2; ++bj) { const u32x4 hw = *(const u32x4*)(hr + bj * HALF);
                    f32x4 v0 = acc[ai][bj][m][0], v1 = acc[ai][bj][m][1];
                    v0[0] += ALPHA * blo(hw.x); v0[1] += ALPHA * bhi(hw.x); v0[2] += ALPHA * blo(hw.y); v0[3] += ALPHA * bhi(hw.y);
                    v1[0] += ALPHA * blo(hw.z); v1[1] += ALPHA * bhi(hw.z); v1[2] += ALPHA * blo(hw.w); v1[3] += ALPHA * bhi(hw.w);
                    *(f32x4*)(yr + bj * HALF) = v0; *(f32x4*)(yr + bj * HALF + 4) = v1; } }
    }
};
struct UpOrder : StaticOrder {
    PG8_LAS float* slots; const float* wcv; const float* bcv; mutable int cnt;
    __device__ __forceinline__ void a_ready(const Unit& u) const {
        PG8_LAS float* sl = slots + (cnt & 1) * 1024; ++cnt;
#pragma unroll
        for (int i = 0; i < 2; ++i) { const int idx = threadIdx.x + 512 * i, p_ = idx >> 8, c = idx & 255; const int nat = (c >> 7) * 2816 + u.pn * 128 + (c & 127);
            sl[idx] = p_ < 3 ? wcv[p_ * 5632 + nat] : bcv[nat]; }
    }
};
__device__ __forceinline__ float dpp_ror1(float v) { const int iv = __float_as_int(v); return __int_as_float(__builtin_amdgcn_update_dpp(iv, iv, 0x121, 0xF, 0xF, false)); }
__device__ __forceinline__ float dpp_ror2(float v) { const int iv = __float_as_int(v); return __int_as_float(__builtin_amdgcn_update_dpp(iv, iv, 0x122, 0xF, 0xF, false)); }
struct EpiUpConv {
    static constexpr bool PERM = true, AFTER_DRAIN = false;
    bf16_t* ACT; bf16_t* BND; bf16_t* UPS; PG8_LAS const float* slots; mutable int cnt;
    __device__ __forceinline__ void operator()(const f32x4 (&acc)[2][2][4][2], const Unit& u, int wr, int wc, int fr, int fq) const {
        const int f0 = u.pn * 128 + wc * 32 + 8 * fq;
        PG8_LAS const float* sl = slots + (cnt & 1) * 1024 + wc * 32 + 8 * fq; ++cnt;
        if (u.pm == 256) {
#pragma unroll
            for (int m = 0; m < 4; ++m) { const int row = wr * 64 + m * 16 + fr;
#pragma unroll
                for (int bj = 0; bj < 2; ++bj) { const f32x4 v0 = acc[0][bj][m][0], v1 = acc[0][bj][m][1]; u32x4 w;
                    w.x = cvt_pk_bf16(v0[0], v0[1]); w.y = cvt_pk_bf16(v0[2], v0[3]); w.z = cvt_pk_bf16(v1[0], v1[1]); w.w = cvt_pk_bf16(v1[2], v1[3]);
                    *(u32x4*)((char*)UPS + ((unsigned)row * 5632u + (unsigned)(bj * 2816 + f0)) * 2u) = w; } }
            return;
        }
#pragma unroll
        for (int ai = 0; ai < 2; ++ai) {
            const int slab = u.pm * 4 + ai * 2 + wr;
            if (fr < 2 || fr >= 14) { const int m = fr < 2 ? 0 : 3; const int ri = fr < 2 ? fr : fr - 12;
#pragma unroll
                for (int bj = 0; bj < 2; ++bj) { const f32x4 v0 = fr < 2 ? acc[ai][bj][0][0] : acc[ai][bj][3][0], v1 = fr < 2 ? acc[ai][bj][0][1] : acc[ai][bj][3][1]; u32x4 w;
                    w.x = cvt_pk_bf16(v0[0], v0[1]); w.y = cvt_pk_bf16(v0[2], v0[3]); w.z = cvt_pk_bf16(v1[0], v1[1]); w.w = cvt_pk_bf16(v1[2], v1[3]);
                    *(u32x4*)((char*)BND + ((unsigned)(slab * 4 + ri) * 5632u + (unsigned)(bj * 2816 + f0)) * 2u) = w; }
                (void)m; }
            const bool g1 = fr >= 1, g2 = fr >= 2;
#pragma unroll
            for (int n = 0; n < 2; ++n) {
                unsigned pk[4][2];
                float aprev[4];
#pragma unroll
                for (int e = 0; e < 4; ++e) {
                    float cv[2][4];
#pragma unroll
                    for (int bj = 0; bj < 2; ++bj) {
                        PG8_LAS const float* sp = sl + bj * 128 + 4 * n + e;
                        const float w0 = sp[0], w1 = sp[256], w2 = sp[512], bb = sp[768];
                        const float v0 = acc[ai][bj][0][n][e], v1 = acc[ai][bj][1][n][e], v2 = acc[ai][bj][2][n][e], v3 = acc[ai][bj][3][n][e];
                        const float a0 = dpp_ror1(v0), a1 = dpp_ror1(v1), a2 = dpp_ror1(v2), a3 = dpp_ror1(v3);
                        const float c0 = dpp_ror2(v0), c1 = dpp_ror2(v1), c2 = dpp_ror2(v2), c3 = dpp_ror2(v3);
                        cv[bj][0] = bb + w2 * v0 + w1 * a0 + w0 * c0;
                        cv[bj][1] = bb + w2 * v1 + w1 * (g1 ? a1 : a0) + w0 * (g2 ? c1 : c0);
                        cv[bj][2] = bb + w2 * v2 + w1 * (g1 ? a2 : a1) + w0 * (g2 ? c2 : c1);
                        cv[bj][3] = bb + w2 * v3 + w1 * (g1 ? a3 : a2) + w0 * (g2 ? c3 : c2); }
#pragma unroll
                    for (int m = 0; m < 4; ++m) { const float a = cv[0][m]; const float r = a * __builtin_amdgcn_rcpf(1.f + __builtin_amdgcn_exp2f(-1.4426950408889634f * a)) * cv[1][m];
                        if (e & 1) pk[m][e >> 1] = cvt_pk_bf16(aprev[m], r); else aprev[m] = r; }
                    __builtin_amdgcn_sched_barrier(0);
                }
#pragma unroll
                for (int m = 0; m < 4; ++m) { if (m == 0 && fr < 2) continue;
                    const int row = u.pm * BM + ai * HALF + wr * 64 + m * 16 + fr;
                    unsigned* dst = (unsigned*)((char*)ACT + ((unsigned)row * 2816u + (unsigned)(f0 + 4 * n)) * 2u);
                    typedef unsigned u32x2 __attribute__((ext_vector_type(2)));
                    *(u32x2*)dst = (u32x2){pk[m][0], pk[m][1]}; }
                __builtin_amdgcn_sched_barrier(0);
            }
        }
    }
};
}

__device__ void transpose_job(const float* __restrict__ src, int K, int N, bf16_t* __restrict__ dst, int mode, int rowoff, float* tile) {
    const int tid = threadIdx.x, ntn = N / 64, ntot = (K / 64) * ntn;
    for (int tix = blockIdx.x; tix < ntot; tix += gridDim.x) {
        const int kt = tix / ntn, nt = tix % ntn;
        __syncthreads();
#pragma unroll
        for (int i = 0; i < 8; ++i) { const int r = (tid >> 6) + 8 * i, c = tid & 63; tile[r * 65 + c] = src[(size_t)(kt * 64 + r) * N + nt * 64 + c]; }
        __syncthreads();
        const int nn = tid >> 3, kk = (tid & 7) * 8, n = nt * 64 + nn; int drow = n;
        if (mode == 1) { const int h = n / 192, d = n % 192; drow = d < 128 ? n : h * 192 + 128 + rope_phys(d - 128); }
        if (mode == 2) { const int part = n / DFF, f = n % DFF; drow = (f >> 7) * 256 + part * 128 + (f & 127); }
        float v[8];
#pragma unroll
        for (int e = 0; e < 8; ++e) v[e] = tile[(kk + e) * 65 + nn];
        u32x4 w; w.x = cvt_pk_bf16(v[0], v[1]); w.y = cvt_pk_bf16(v[2], v[3]); w.z = cvt_pk_bf16(v[4], v[5]); w.w = cvt_pk_bf16(v[6], v[7]);
        *(u32x4*)(dst + (size_t)(drow + rowoff) * K + kt * 64 + kk) = w;
    }
}
__device__ void p0_prologue(const Params& P, unsigned char* lds) {
    const int tid = threadIdx.x; const long gtid = blockIdx.x * 512L + tid, gsz = gridDim.x * 512L;
    unsigned char* ws = P.ws;
    {
        bf16_t* XB = (bf16_t*)(ws + WS_XB); const long n8 = (long)TOKP * 1024 / 8;
        for (long i = gtid; i < n8; i += gsz) { const long e = i * 8, row = e >> 10; u32x4 w = {0u, 0u, 0u, 0u};
            if (row < TOK) { const float* s = row < TP ? P.in[0] + e : P.in[1] + (e - (long)TP * 1024);
                const f32x4 a = *(const f32x4*)s, b = *(const f32x4*)(s + 4);
                w.x = cvt_pk_bf16(a[0], a[1]); w.y = cvt_pk_bf16(a[2], a[3]); w.z = cvt_pk_bf16(b[0], b[1]); w.w = cvt_pk_bf16(b[2], b[3]); }
            *(u32x4*)(XB + e) = w; }
    }
    {
        bf16_t* CK = (bf16_t*)(ws + WS_CKVN); const long n8 = 8L * 2048 * 256 / 8;
        for (long i = gtid; i < n8; i += gsz) { const long e = i * 8; const int r = (int)(e >> 8), c = (int)(e & 255), b = r >> 11, p = r & 2047;
            const float* s = P.in[2] + e; const f32x4 a = *(const f32x4*)s, bb = *(const f32x4*)(s + 4); u32x4 w;
            w.x = cvt_pk_bf16(a[0], a[1]); w.y = cvt_pk_bf16(a[2], a[3]); w.z = cvt_pk_bf16(bb[0], bb[1]); w.w = cvt_pk_bf16(bb[2], bb[3]);
            *(u32x4*)(CK + (size_t)(TP + b * KVS + p) * 256 + c) = w; }
        for (long i = gtid; i < (long)(KVRP - KVR) * 256; i += gsz) CK[(size_t)KVR * 256 + i] = 0;
        bf16_t* KP = (bf16_t*)(ws + WS_KPE);
        for (long i = gtid; i < 8L * 2048 * 64; i += gsz) { const int r = (int)(i >> 6), d = (int)(i & 63), b = r >> 11, p = r & 2047;
            KP[(size_t)(TP + b * KVS + p) * 64 + rope_phys(d)] = f2bf(P.in[3][i]); }
        for (long i = gtid; i < (long)(KVRP - KVR) * 64; i += gsz) KP[(size_t)KVR * 64 + i] = 0;
    }
    {
        float* RT = (float*)(ws + WS_ROPE);
        for (long i = gtid; i < 8192L * 32; i += gsz) { const int pos = (int)(i >> 5), k = (int)(i & 31);
            const float invf = exp2f(-(float)k * (13.287712379549449f / 32.f)); const float ang = (float)pos * invf;
            double rev = (double)ang * 0.15915494309189535; rev -= floor(rev); const float fr = (float)rev;
            RT[i * 2] = __builtin_amdgcn_cosf(fr); RT[i * 2 + 1] = __builtin_amdgcn_sinf(fr); }
    }
    {
        bf16_t* WP = (bf16_t*)(ws + WS_WSP); bf16_t* WS_ = (bf16_t*)(ws + WS_WSS); const float* w_s = P.in[8];
        for (long i = gtid; i < 4L * 128 * 128; i += gsz) { const int h = (int)(i >> 14), r = (int)(i >> 7) & 127, c = (int)i & 127;
            WP[i] = ((c >> 6) <= (r >> 6)) ? f2bf(w_s[i]) : (bf16_t)0;
            WS_[i] = ((r >> 4) == (c >> 4)) ? f2bf(w_s[h * 16384 + (r & 15) * 128 + (c & 15)]) : (bf16_t)0; }
        bf16_t* WI = (bf16_t*)(ws + WS_WIN);
        for (long i = gtid; i < 64L * 1024; i += gsz) WI[(size_t)1728 * 1024 + i] = 0;
    }
    float* tile = (float*)lds;
    transpose_job(P.in[5], 1024, 1728, (bf16_t*)(ws + WS_WIN), 0, 0, tile);
    transpose_job(P.in[11], 384, 768, (bf16_t*)(ws + WS_WUQ), 1, 0, tile);
    transpose_job(P.in[13], 256, 512, (bf16_t*)(ws + WS_WKV), 0, 0, tile);
    transpose_job(P.in[14], 256, 512, (bf16_t*)(ws + WS_WKV), 0, 512, tile);
    transpose_job(P.in[15], 1024, 1024, (bf16_t*)(ws + WS_WO), 0, 0, tile);
    transpose_job(P.in[18], 1024, DFF2, (bf16_t*)(ws + WS_WUP), 2, 0, tile);
    transpose_job(P.in[21], DFF, 1024, (bf16_t*)(ws + WS_WDN), 0, 0, tile);
    __syncthreads();
}

__device__ void p2_token(const Params& P) {
    unsigned char* ws = P.ws; const int lane = threadIdx.x & 63; const int gw = blockIdx.x * 8 + (threadIdx.x >> 6), nw = gridDim.x * 8;
    const bf16_t* PROJ = (const bf16_t*)(ws + WS_PROJ); bf16_t* VN = (bf16_t*)(ws + WS_VN); bf16_t* CQN = (bf16_t*)(ws + WS_CQN);
    bf16_t* CK = (bf16_t*)(ws + WS_CKVN); bf16_t* KP = (bf16_t*)(ws + WS_KPE); const float* RT = (const float*)(ws + WS_ROPE);
    const float* lng = P.in[6]; const float* lnb = P.in[7]; const float* gq = P.in[10]; const float* gkv = P.in[12];
    float g8[8], b8[8];
#pragma unroll
    for (int e = 0; e < 8; ++e) { g8[e] = lng[lane * 8 + e]; b8[e] = lnb[lane * 8 + e]; }
    float gq6[6], gk4[4];
#pragma unroll
    for (int i = 0; i < 3; ++i) { gq6[2 * i] = gq[128 * i + 2 * lane]; gq6[2 * i + 1] = gq[128 * i + 2 * lane + 1]; }
#pragma unroll
    for (int e = 0; e < 4; ++e) gk4[e] = gkv[lane * 4 + e];
    const int kphys = rope_phys(lane);
    for (int t0 = gw * 4; t0 < TOK; t0 += nw * 4) {
        u32x4 rv[4]; unsigned rq[4][3], rk[4][2]; unsigned short rp[4];
#pragma unroll
        for (int r = 0; r < 4; ++r) { const bf16_t* pr = PROJ + (size_t)(t0 + r) * NIN;
            rv[r] = *(const u32x4*)(pr + 512 + lane * 8);
#pragma unroll
            for (int i = 0; i < 3; ++i) rq[r][i] = *(const unsigned*)(pr + 1024 + 128 * i + 2 * lane);
            rk[r][0] = *(const unsigned*)(pr + 1408 + lane * 4); rk[r][1] = *(const unsigned*)(pr + 1408 + lane * 4 + 2);
            rp[r] = pr[1664 + lane]; }
#pragma unroll
        for (int r = 0; r < 4; ++r) { const int t = t0 + r;
        const int kvrow = t < TP ? t : TP + ((t - TP) >> 4) * KVS + 2048 + (t & 15);
        {
            const u32x4 w = rv[r];
            float x[8] = {blo(w.x), bhi(w.x), blo(w.y), bhi(w.y), blo(w.z), bhi(w.z), blo(w.w), bhi(w.w)};
            float s = 0.f;
#pragma unroll
            for (int e = 0; e < 8; ++e) s += x[e];
            const float mu = wsum(s) * (1.f / 512.f); float q = 0.f;
#pragma unroll
            for (int e = 0; e < 8; ++e) { x[e] -= mu; q += x[e] * x[e]; }
            const float rstd = rsqrtf(wsum(q) * (1.f / 512.f) + 1e-5f);
#pragma unroll
            for (int e = 0; e < 8; ++e) x[e] = x[e] * rstd * g8[e] + b8[e];
            u32x4 o; o.x = cvt_pk_bf16(x[0], x[1]); o.y = cvt_pk_bf16(x[2], x[3]); o.z = cvt_pk_bf16(x[4], x[5]); o.w = cvt_pk_bf16(x[6], x[7]);
            *(u32x4*)(VN + (size_t)t * 512 + lane * 8) = o;
            if (t >= TP) { float* go = P.out + O_GVS + (size_t)(t - TP) * 512 + lane * 8;
                *(f32x4*)go = (f32x4){x[0], x[1], x[2], x[3]}; *(f32x4*)(go + 4) = (f32x4){x[4], x[5], x[6], x[7]}; }
        }
        {
            float x[6]; float q = 0.f;
#pragma unroll
            for (int i = 0; i < 3; ++i) { const unsigned w = rq[r][i]; x[2 * i] = blo(w); x[2 * i + 1] = bhi(w); q += x[2 * i] * x[2 * i] + x[2 * i + 1] * x[2 * i + 1]; }
            const float rstd = rsqrtf(wsum(q) * (1.f / 384.f) + 1e-6f);
#pragma unroll
            for (int i = 0; i < 3; ++i) *(unsigned*)(CQN + (size_t)t * 384 + 128 * i + 2 * lane) = cvt_pk_bf16(x[2 * i] * rstd * gq6[2 * i], x[2 * i + 1] * rstd * gq6[2 * i + 1]);
        }
        {
            const unsigned w0 = rk[r][0], w1 = rk[r][1];
            float x[4] = {blo(w0), bhi(w0), blo(w1), bhi(w1)};
            const float rstd = rsqrtf(wsum(x[0] * x[0] + x[1] * x[1] + x[2] * x[2] + x[3] * x[3]) * (1.f / 256.f) + 1e-6f);
#pragma unroll
            for (int e = 0; e < 4; ++e) x[e] = x[e] * rstd * gk4[e];
            float* co = P.out + (t < TP ? O_CKVP + (size_t)t * 256 : O_CKVS + (size_t)(t - TP) * 256) + lane * 4;
            *(f32x4*)co = (f32x4){x[0], x[1], x[2], x[3]};
            unsigned* ck = (unsigned*)(CK + (size_t)kvrow * 256 + lane * 4); ck[0] = cvt_pk_bf16(x[0], x[1]); ck[1] = cvt_pk_bf16(x[2], x[3]);
        }
        {
            const float x = bf2f(rp[r]); const float other = __shfl_xor(x, 32); const int i = lane & 31, pos = tok_pos(t);
            const float c = RT[((size_t)pos * 32 + i) * 2], s = RT[((size_t)pos * 32 + i) * 2 + 1];
            const float o = lane < 32 ? x * c - other * s : x * c + other * s;
            P.out[(t < TP ? O_KPEP + (size_t)t * 64 : O_KPES + (size_t)(t - TP) * 64) + lane] = o;
            KP[(size_t)kvrow * 64 + kphys] = f2bf(o);
        }
        }
    }
}

__device__ __forceinline__ int crow(int r, int hi) { return (r & 3) + 8 * (r >> 2) + 4 * hi; }
__device__ void spatial_phase(const Params& P, unsigned char* lds) {
    unsigned char* ws = P.ws; const int tid = threadIdx.x, wid = tid >> 6, lane = tid & 63, r32 = lane & 31, hi = lane >> 5;
    const bf16_t* PROJ = (const bf16_t*)(ws + WS_PROJ); const bf16_t* VN = (const bf16_t*)(ws + WS_VN); bf16_t* CAT = (bf16_t*)(ws + WS_CAT);
    bf16_t* VT = (bf16_t*)lds;
    const float* bs = P.in[9];
    for (int unit = blockIdx.x; unit < 513 * 4; unit += gridDim.x) {
        const int c = unit >> 2, h = unit & 3, tok0 = c * 128; const bool sample = (c == 512);
        const bf16_t* Wm = (const bf16_t*)(ws + (sample ? WS_WSS : WS_WSP)) + h * 16384;
        __syncthreads();
        {   const int j = tid >> 2, dq = (tid & 3) * 32; const bf16_t* src = VN + (size_t)(tok0 + j) * 512 + h * 128 + dq;
#pragma unroll
            for (int i = 0; i < 4; ++i) { const u32x4 w = *(const u32x4*)(src + 8 * i); const unsigned ww[4] = {w.x, w.y, w.z, w.w};
#pragma unroll
                for (int e = 0; e < 4; ++e) { VT[(dq + 8 * i + 2 * e) * 136 + j] = (bf16_t)(ww[e] & 0xffffu); VT[(dq + 8 * i + 2 * e + 1) * 136 + j] = (bf16_t)(ww[e] >> 16); } }
        }
        __syncthreads();
        const int ib = wid >> 1, db0 = (wid & 1) * 2;
        f32x16 a0 = {}, a1 = {};
#pragma unroll
        for (int k = 0; k < 8; ++k) {
            const bf16x8 a = *(const bf16x8*)(Wm + (ib * 32 + r32) * 128 + k * 16 + hi * 8);
            const bf16x8 b0 = *(const bf16x8*)(VT + (db0 * 32 + r32) * 136 + k * 16 + hi * 8);
            const bf16x8 b1 = *(const bf16x8*)(VT + ((db0 + 1) * 32 + r32) * 136 + k * 16 + hi * 8);
            a0 = __builtin_amdgcn_mfma_f32_32x32x16_bf16(a, b0, a0, 0, 0, 0);
            a1 = __builtin_amdgcn_mfma_f32_32x32x16_bf16(a, b1, a1, 0, 0, 0);
        }
#pragma unroll
        for (int r = 0; r < 16; ++r) { const int i = ib * 32 + crow(r, hi), tok = tok0 + i; const float bias = bs[h * 128 + (sample ? (i & 15) : i)];
            const int d0 = h * 128 + db0 * 32 + r32;
            const float u0 = bf2f(PROJ[(size_t)tok * NIN + d0]), u1 = bf2f(PROJ[(size_t)tok * NIN + d0 + 32]);
            CAT[(size_t)tok * 1024 + d0] = f2bf(u0 * (a0[r] + bias)); CAT[(size_t)tok * 1024 + d0 + 32] = f2bf(u1 * (a1[r] + bias)); }
    }
    __syncthreads();
}

namespace att {
constexpr int SHM_V = 16384, SHM_K = 16384, SHM_P = 8192;
constexpr int OFF_V = 0, OFF_K = 2 * SHM_V, OFF_P = OFF_K + 2 * SHM_K, OFF_WS = OFF_P + 2 * SHM_P;
#define KSWZ(row, colB) ((row) * 256 + ((colB) ^ (((row) & 7) << 4)))
#define PSWZ(row, colB) ((row) * 128 + ((colB) ^ (((row) & 7) << 4)))
#define SBAR() __builtin_amdgcn_sched_barrier(0)
__device__ __forceinline__ int v_st(int k, int c) { const int kk = (k & ~0xC) | ((k & 4) << 1) | ((k & 8) >> 1); return ((kk >> 3) * 4 + (c >> 5)) * 512 + ((kk & 7) * 32 + (c & 31)) * 2; }
__device__ __forceinline__ int v_rd_base(int lane) { return ((lane & 3) << 3) | (((lane >> 2) & 3) << 6) | (((lane >> 4) & 1) << 5) | (((lane >> 5) & 1) << 8); }
constexpr int v_rd_off(int d0, int ks, int half) { return d0 * 512 + ks * 4096 + half * 2048; }
template <int OFF> __device__ __forceinline__ s16x4 tr_read(int vb) {
    s16x4 r; asm volatile("ds_read_b64_tr_b16 %0, %1 offset:%2" : "=&v"(r) : "v"(vb), "i"(OFF) : "memory"); return r; }
template <int D0> __device__ __forceinline__ void pv_one(f32x16& od, int vb, bf16x8 pa0, bf16x8 pa1, bf16x8 pa2, bf16x8 pa3) {
    const s16x4 l0 = tr_read<v_rd_off(D0, 0, 0)>(vb), h0 = tr_read<v_rd_off(D0, 0, 1)>(vb), l1 = tr_read<v_rd_off(D0, 1, 0)>(vb), h1 = tr_read<v_rd_off(D0, 1, 1)>(vb);
    const s16x4 l2 = tr_read<v_rd_off(D0, 2, 0)>(vb), h2 = tr_read<v_rd_off(D0, 2, 1)>(vb), l3 = tr_read<v_rd_off(D0, 3, 0)>(vb), h3 = tr_read<v_rd_off(D0, 3, 1)>(vb);
    asm volatile("s_waitcnt lgkmcnt(0)" ::: "memory"); SBAR();
#define PK(L, H) (bf16x8){L[0], L[1], L[2], L[3], H[0], H[1], H[2], H[3]}
    od = __builtin_amdgcn_mfma_f32_32x32x16_bf16(pa0, PK(l0, h0), od, 0, 0, 0);
    od = __builtin_amdgcn_mfma_f32_32x32x16_bf16(pa1, PK(l1, h1), od, 0, 0, 0);
    od = __builtin_amdgcn_mfma_f32_32x32x16_bf16(pa2, PK(l2, h2), od, 0, 0, 0);
    od = __builtin_amdgcn_mfma_f32_32x32x16_bf16(pa3, PK(l3, h3), od, 0, 0, 0);
#undef PK
}
__device__ __forceinline__ void attn_unit(const bf16_t* __restrict__ Qrow  , const float* __restrict__ ropeRow  ,
                                          const bf16_t* __restrict__ KVh  ,
                                          const bf16_t* __restrict__ KPh  , bf16_t* __restrict__ Orow0  ,
                                          int orows  , int NT, int nact, int kvalid, unsigned char* lds) {
    const int tid = threadIdx.x, wid = __builtin_amdgcn_readfirstlane(tid >> 6), lane = tid & 63, r32 = lane & 31, hi = lane >> 5;
    unsigned char* V_lds = lds + OFF_V; unsigned char* K_lds = lds + OFF_K; unsigned char* P_lds = lds + OFF_P;
    float* wsf = (float*)(lds + OFF_WS) + wid * 64; float* li_l = wsf; float* al_l = wsf + 32;
    float m_reg = -1e30f, l_reg = 0.f; f32x16 o[4] = {}; bf16x8 qr[12];
#pragma unroll
    for (int d0 = 0; d0 < 12; ++d0) qr[d0] = *(const bf16x8*)(Qrow + hi * 8 + d0 * 16);
#pragma unroll
    for (int d0 = 0; d0 < 4; ++d0) {
        const int i0 = (d0 >> 1) * 16 + ((d0 & 1) * 2 + hi) * 4; const float* rp = ropeRow + i0 * 2;
        const f32x4 c01 = *(const f32x4*)rp, c23 = *(const f32x4*)(rp + 4);
        const float cs[4] = {c01[0], c01[2], c23[0], c23[2]}, sn[4] = {c01[1], c01[3], c23[1], c23[3]};
        const u32x4 w = *reinterpret_cast<const u32x4*>(&qr[8 + d0]);
        const float x1[4] = {blo(w.x), bhi(w.x), blo(w.y), bhi(w.y)}, x2[4] = {blo(w.z), bhi(w.z), blo(w.w), bhi(w.w)};
        float y1[4], y2[4];
#pragma unroll
        for (int e = 0; e < 4; ++e) { y1[e] = x1[e] * cs[e] - x2[e] * sn[e]; y2[e] = x2[e] * cs[e] + x1[e] * sn[e]; }
        u32x4 ow; ow.x = cvt_pk_bf16(y1[0], y1[1]); ow.y = cvt_pk_bf16(y1[2], y1[3]); ow.z = cvt_pk_bf16(y2[0], y2[1]); ow.w = cvt_pk_bf16(y2[2], y2[3]);
        qr[8 + d0] = *reinterpret_cast<bf16x8*>(&ow);
    }
    int kofs[2], vofs[2], pofs;
#pragma unroll
    for (int i = 0; i < 2; ++i) { const int c = wid + 8 * i;
        { const int row = 4 * c + (lane >> 4), colB = ((lane & 15) * 16) ^ ((row & 7) << 4); kofs[i] = row * 1024 + (colB >> 1); }
        { const int st = 2 * c + (lane >> 5), kk = (st >> 2) * 8 + ((lane & 31) >> 2), col = (st & 3) * 32 + (lane & 3) * 8;
          const int k = (kk & ~0xC) | ((kk & 4) << 1) | ((kk & 8) >> 1); vofs[i] = k * 1024 + 512 + col; } }
    { const int row = wid * 8 + (lane >> 3), colB = ((lane & 7) * 16) ^ ((row & 7) << 4); pofs = row * 64 + (colB >> 1); }
    const int vb0 = (int)(uintptr_t)(V_lds) + v_rd_base(lane);
#define GLDS(gp, lp) __builtin_amdgcn_global_load_lds((const unsigned*)(gp), (PG8_LAS unsigned*)(lp), 16, 0, 0)
#define STAGE_T(k0, b) do { const bf16_t* kb_ = KVh + (size_t)(k0) * 1024; \
        GLDS(kb_ + kofs[0], K_lds + (b) * SHM_K + wid * 1024); GLDS(kb_ + kofs[1], K_lds + (b) * SHM_K + (wid + 8) * 1024); \
        GLDS(kb_ + vofs[0], V_lds + (b) * SHM_V + wid * 1024); GLDS(kb_ + vofs[1], V_lds + (b) * SHM_V + (wid + 8) * 1024); \
        GLDS(KPh + (size_t)(k0) * 64 + pofs, P_lds + (b) * SHM_P + wid * 1024); } while (0)
    STAGE_T(0, 0); asm volatile("s_waitcnt vmcnt(0)" ::: "memory"); __syncthreads();
    for (int j = 0; j < NT; ++j) {
        const int buf = j & 1; const bool more = (j + 1 < NT);
        if (more) STAGE_T((j + 1) * 64, buf ^ 1);
        if (j < nact) {
            const unsigned char* Ks = K_lds + buf * SHM_K; const unsigned char* Ps = P_lds + buf * SHM_P;
            f32x16 p0 = {}, p1 = {};
#pragma unroll
            for (int d0 = 0; d0 < 8; ++d0) { const int cb = (d0 * 16 + hi * 8) * 2;
                const bf16x8 b0 = *(const bf16x8*)(Ks + KSWZ(r32, cb)), b1 = *(const bf16x8*)(Ks + KSWZ(32 + r32, cb));
                p0 = __builtin_amdgcn_mfma_f32_32x32x16_bf16(b0, qr[d0], p0, 0, 0, 0); p1 = __builtin_amdgcn_mfma_f32_32x32x16_bf16(b1, qr[d0], p1, 0, 0, 0); }
#pragma unroll
            for (int d0 = 0; d0 < 4; ++d0) { const int cb = (d0 * 16 + hi * 8) * 2;
                const bf16x8 b0 = *(const bf16x8*)(Ps + PSWZ(r32, cb)), b1 = *(const bf16x8*)(Ps + PSWZ(32 + r32, cb));
                p0 = __builtin_amdgcn_mfma_f32_32x32x16_bf16(b0, qr[8 + d0], p0, 0, 0, 0); p1 = __builtin_amdgcn_mfma_f32_32x32x16_bf16(b1, qr[8 + d0], p1, 0, 0, 0); }
            if (j == NT - 1 && kvalid < 64) {
#pragma unroll
                for (int r = 0; r < 16; ++r) { if (crow(r, hi) >= kvalid) p0[r] = -1e30f; if (32 + crow(r, hi) >= kvalid) p1[r] = -1e30f; } }
            float pmax = p0[0];
#pragma unroll
            for (int r = 1; r < 16; ++r) pmax = fmaxf(pmax, p0[r]);
#pragma unroll
            for (int r = 0; r < 16; ++r) pmax = fmaxf(pmax, p1[r]);
            { auto rr = __builtin_amdgcn_permlane32_swap(__float_as_uint(pmax), __float_as_uint(pmax), false, false); pmax = fmaxf(__uint_as_float(rr[0]), __uint_as_float(rr[1])); }
            const float mn = fmaxf(m_reg, pmax); const float alpha = __builtin_amdgcn_exp2f(m_reg - mn); m_reg = mn;
            float ps = 0.f;
#pragma unroll
            for (int r = 0; r < 16; ++r) { p0[r] = __builtin_amdgcn_exp2f(p0[r] - mn); p1[r] = __builtin_amdgcn_exp2f(p1[r] - mn); ps += p0[r] + p1[r]; }
            { auto rr = __builtin_amdgcn_permlane32_swap(__float_as_uint(ps), __float_as_uint(ps), false, false); ps = __uint_as_float(rr[0]) + __uint_as_float(rr[1]); }
            l_reg = l_reg * alpha + ps;
            bf16x8 pa0, pa1, pa2, pa3;
#define PK4(Pv, BASE, OUT) do { unsigned a0 = cvt_pk_bf16(Pv[BASE + 0], Pv[BASE + 1]), a1 = cvt_pk_bf16(Pv[BASE + 2], Pv[BASE + 3]); \
        unsigned b0_ = cvt_pk_bf16(Pv[BASE + 4], Pv[BASE + 5]), b1_ = cvt_pk_bf16(Pv[BASE + 6], Pv[BASE + 7]); \
        auto r0 = __builtin_amdgcn_permlane32_swap(a0, b0_, false, false); auto r1 = __builtin_amdgcn_permlane32_swap(a1, b1_, false, false); \
        u32x4 w_ = {r0[0], r1[0], r0[1], r1[1]}; OUT = *reinterpret_cast<bf16x8*>(&w_); } while (0)
            PK4(p0, 0, pa0); PK4(p0, 8, pa1); PK4(p1, 0, pa2); PK4(p1, 8, pa3);
#undef PK4
            if (__any(alpha < 1.f)) { if (hi == 0) al_l[r32] = alpha; asm volatile("s_waitcnt lgkmcnt(0)" ::: "memory");
#pragma unroll
                for (int r = 0; r < 16; ++r) { const float a = al_l[crow(r, hi)];
#pragma unroll
                    for (int d = 0; d < 4; ++d) o[d][r] *= a; } }
            const int vb = vb0 + buf * SHM_V;
            pv_one<0>(o[0], vb, pa0, pa1, pa2, pa3); pv_one<1>(o[1], vb, pa0, pa1, pa2, pa3); pv_one<2>(o[2], vb, pa0, pa1, pa2, pa3); pv_one<3>(o[3], vb, pa0, pa1, pa2, pa3);
        }
        asm volatile("s_waitcnt vmcnt(0)" ::: "memory");
        __syncthreads();
    }
#undef STAGE_T
#undef GLDS
    if (nact > 0) {
        if (hi == 0) li_l[r32] = l_reg; asm volatile("s_waitcnt lgkmcnt(0)" ::: "memory");
#pragma unroll
        for (int r = 0; r < 16; ++r) { const int orow = crow(r, hi); if (orow < orows) { const float rl = __builtin_amdgcn_rcpf(li_l[orow]);
#pragma unroll
            for (int d0 = 0; d0 < 4; ++d0) Orow0[(size_t)orow * 1024 + d0 * 32 + r32] = f2bf(o[d0][r] * rl); } }
    }
}
__device__ void attn_phase(const Params& P, unsigned char* lds) {
    unsigned char* ws = P.ws; const int tid = threadIdx.x, wid = tid >> 6, lane = tid & 63, r32 = lane & 31;
    const bf16_t* QB = (const bf16_t*)(ws + WS_QB); const bf16_t* KVB = (const bf16_t*)(ws + WS_KVB); const bf16_t* KPE = (const bf16_t*)(ws + WS_KPE); bf16_t* CAT = (bf16_t*)(ws + WS_CAT); const float* RT = (const float*)(ws + WS_ROPE);
    for (int pr = blockIdx.x; pr < 512; pr += gridDim.x) {
        const int c = pr & 255, rnd = pr >> 8, xcd = c & 7, slot = c >> 3, bh = rnd * 16 + xcd * 2 + (slot >> 4), x = slot & 15, b = bh >> 2, h = bh & 3;
#pragma unroll 1
        for (int s = 0; s < 2; ++s) { const int qb = s == 0 ? 31 - x : x; const int q0 = b * 8192 + qb * 256 + wid * 32;
            attn_unit(QB + (size_t)(q0 + r32) * 768 + h * 192, RT + (size_t)((q0 + r32) & 8191) * 64, KVB + (size_t)(b * 8192) * 1024 + h * 128, KPE + (size_t)(b * 8192) * 64,
                      CAT + (size_t)q0 * 1024 + 512 + h * 128, 32, 4 * qb + 4, 4 * qb + 1 + (wid >> 1), 64, lds); }
    }
    for (int su = blockIdx.x; su < 32; su += gridDim.x) { const int b = su >> 2, h = su & 3; const int q0 = TP + b * 16;
        attn_unit(QB + (size_t)(q0 + (r32 & 15)) * 768 + h * 192, RT + (size_t)(2048 + (r32 & 15)) * 64, KVB + (size_t)(TP + b * KVS) * 1024 + h * 128, KPE + (size_t)(TP + b * KVS) * 64,
                  CAT + (size_t)q0 * 1024 + 512 + h * 128, 16, 33, wid == 0 ? 33 : 0, 16, lds); }
}
}

__device__ void ln1_phase(const Params& P) {
    unsigned char* ws = P.ws; const int lane = threadIdx.x & 63; const int gw = blockIdx.x * 8 + (threadIdx.x >> 6), nw = gridDim.x * 8;
    const bf16_t* R1 = (const bf16_t*)(ws + WS_R1); bf16_t* H = (bf16_t*)(ws + WS_H); const float* g = P.in[16]; const float* bb = P.in[17];
    float gg[16], bv[16];
#pragma unroll
    for (int e = 0; e < 8; ++e) { gg[e] = g[lane * 8 + e]; gg[8 + e] = g[512 + lane * 8 + e]; bv[e] = bb[lane * 8 + e]; bv[8 + e] = bb[512 + lane * 8 + e]; }
    for (int t0 = gw * 4; t0 < TOK; t0 += nw * 4) {
        u32x4 w0[4], w1[4];
#pragma unroll
        for (int r = 0; r < 4; ++r) { const int t = (t0 + r < TOK) ? t0 + r : TOK - 1; w0[r] = *(const u32x4*)(R1 + (size_t)t * 1024 + lane * 8); w1[r] = *(const u32x4*)(R1 + (size_t)t * 1024 + 512 + lane * 8); }
#pragma unroll
        for (int r = 0; r < 4; ++r) { const int t = t0 + r;
            float x[16] = {blo(w0[r].x), bhi(w0[r].x), blo(w0[r].y), bhi(w0[r].y), blo(w0[r].z), bhi(w0[r].z), blo(w0[r].w), bhi(w0[r].w), blo(w1[r].x), bhi(w1[r].x), blo(w1[r].y), bhi(w1[r].y), blo(w1[r].z), bhi(w1[r].z), blo(w1[r].w), bhi(w1[r].w)};
            float s_ = 0.f;
#pragma unroll
            for (int e = 0; e < 16; ++e) s_ += x[e];
            const float mu = wsum(s_) * (1.f / 1024.f); float q = 0.f;
#pragma unroll
            for (int e = 0; e < 16; ++e) { x[e] -= mu; q += x[e] * x[e]; }
            const float rstd = rsqrtf(wsum(q) * (1.f / 1024.f) + 1e-5f);
#pragma unroll
            for (int e = 0; e < 16; ++e) x[e] = x[e] * rstd * gg[e] + bv[e];
            u32x4 o0, o1; o0.x = cvt_pk_bf16(x[0], x[1]); o0.y = cvt_pk_bf16(x[2], x[3]); o0.z = cvt_pk_bf16(x[4], x[5]); o0.w = cvt_pk_bf16(x[6], x[7]);
            o1.x = cvt_pk_bf16(x[8], x[9]); o1.y = cvt_pk_bf16(x[10], x[11]); o1.z = cvt_pk_bf16(x[12], x[13]); o1.w = cvt_pk_bf16(x[14], x[15]);
            if (t < TOK) { *(u32x4*)(H + (size_t)t * 1024 + lane * 8) = o0; *(u32x4*)(H + (size_t)t * 1024 + 512 + lane * 8) = o1; }
        }
    }
}
__device__ void ln2_phase(const Params& P) {
    const int lane = threadIdx.x & 63; const int gw = blockIdx.x * 8 + (threadIdx.x >> 6), nw = gridDim.x * 8;
    float* Y = P.out + O_YP; const float* g = P.in[22]; const float* bb = P.in[23];
    f32x4 gg[4], bv[4];
#pragma unroll
    for (int i = 0; i < 4; ++i) { gg[i] = *(const f32x4*)(g + i * 256 + lane * 4); bv[i] = *(const f32x4*)(bb + i * 256 + lane * 4); }
    for (int t0 = gw * 4; t0 < TOK; t0 += nw * 4) {
        f32x4 x[4][4];
#pragma unroll
        for (int r = 0; r < 4; ++r) { const int t = (t0 + r < TOK) ? t0 + r : TOK - 1;
#pragma unroll
            for (int i = 0; i < 4; ++i) x[r][i] = *(const f32x4*)(Y + (size_t)t * 1024 + i * 256 + lane * 4); }
#pragma unroll
        for (int r = 0; r < 4; ++r) { const int t = t0 + r; float s_ = 0.f;
#pragma unroll
            for (int i = 0; i < 4; ++i) s_ += (x[r][i][0] + x[r][i][1]) + (x[r][i][2] + x[r][i][3]);
            const float mu = wsum(s_) * (1.f / 1024.f); float q = 0.f;
#pragma unroll
            for (int i = 0; i < 4; ++i) { x[r][i] = x[r][i] - mu; q += (x[r][i][0] * x[r][i][0] + x[r][i][1] * x[r][i][1]) + (x[r][i][2] * x[r][i][2] + x[r][i][3] * x[r][i][3]); }
            const float rstd = rsqrtf(wsum(q) * (1.f / 1024.f) + 1e-5f);
            if (t < TOK) {
#pragma unroll
                for (int i = 0; i < 4; ++i) *(f32x4*)(Y + (size_t)t * 1024 + i * 256 + lane * 4) = x[r][i] * rstd * gg[i] + bv[i]; }
        }
    }
}
__device__ __forceinline__ void ld8bf(const bf16_t* p, float* x) { const u32x4 w = *(const u32x4*)p; x[0] = blo(w.x); x[1] = bhi(w.x); x[2] = blo(w.y); x[3] = bhi(w.y); x[4] = blo(w.z); x[5] = bhi(w.z); x[6] = blo(w.w); x[7] = bhi(w.w); }
__device__ __forceinline__ void ld8f(const float* p, float* x) { const f32x4 a = *(const f32x4*)p, b = *(const f32x4*)(p + 4); x[0] = a[0]; x[1] = a[1]; x[2] = a[2]; x[3] = a[3]; x[4] = b[0]; x[5] = b[1]; x[6] = b[2]; x[7] = b[3]; }
__device__ void ffn_fix_phase(const Params& P) {
    unsigned char* ws = P.ws; const long gtid = blockIdx.x * 512L + threadIdx.x, gsz = gridDim.x * 512L;
    const bf16_t* BND = (const bf16_t*)(ws + WS_BND); const bf16_t* UPS = (const bf16_t*)(ws + WS_UPS); bf16_t* ACT = (bf16_t*)(ws + WS_ACT);
    const float* wc = P.in[19]; const float* bc = P.in[20]; const float* st = P.in[4];
    const long n_p = 1024L * 2 * 352, n_s = 128L * 352;
    for (long it = gtid; it < n_p + n_s; it += gsz) {
        const bool samp = it >= n_p; const long q = samp ? it - n_p : it;
        const int f = (int)(q % 352) * 8; const int rr = (int)(q / 352);
        int t; float res[2][8];
#pragma unroll
        for (int part = 0; part < 2; ++part) { const int col = f + part * DFF; float x2[8], x1[8], x0[8];
            if (!samp) { const int s_ = rr >> 1, r = rr & 1; t = s_ * 64 + r; const bool first = (s_ & 127) == 0;
                const bf16_t* B = BND + (size_t)s_ * 4 * DFF2 + col;
                ld8bf(B + (size_t)r * DFF2, x2);
                if (r == 1) ld8bf(B, x1); else if (!first) ld8bf(B - (size_t)1 * DFF2, x1); else {
#pragma unroll
                    for (int e = 0; e < 8; ++e) x1[e] = 0.f; }
                if (!first) ld8bf(B - (size_t)(r == 1 ? 1 : 2) * DFF2, x0); else {
#pragma unroll
                    for (int e = 0; e < 8; ++e) x0[e] = 0.f; }
            } else { const int pos = rr & 15, sb = rr >> 4; t = TP + rr;
                ld8bf(UPS + (size_t)rr * DFF2 + col, x2);
                if (pos >= 1) ld8bf(UPS + (size_t)(rr - 1) * DFF2 + col, x1); else ld8f(st + ((size_t)sb * 2 + 1) * DFF2 + col, x1);
                if (pos >= 2) ld8bf(UPS + (size_t)(rr - 2) * DFF2 + col, x0); else ld8f(st + ((size_t)sb * 2 + pos) * DFF2 + col, x0);
            }
            float w2[8], w1[8], w0[8], bb[8]; ld8f(wc + 2 * DFF2 + col, w2); ld8f(wc + DFF2 + col, w1); ld8f(wc + col, w0); ld8f(bc + col, bb);
#pragma unroll
            for (int e = 0; e < 8; ++e) res[part][e] = bb[e] + w2[e] * x2[e] + w1[e] * x1[e] + w0[e] * x0[e];
        }
        u32x4 o;
        o.x = cvt_pk_bf16(silu(res[0][0]) * res[1][0], silu(res[0][1]) * res[1][1]); o.y = cvt_pk_bf16(silu(res[0][2]) * res[1][2], silu(res[0][3]) * res[1][3]);
        o.z = cvt_pk_bf16(silu(res[0][4]) * res[1][4], silu(res[0][5]) * res[1][5]); o.w = cvt_pk_bf16(silu(res[0][6]) * res[1][6], silu(res[0][7]) * res[1][7]);
        *(u32x4*)(ACT + (size_t)t * DFF + f) = o;
    }
    for (long it = gtid; it < 2L * 16 * DFF2; it += gsz) { const int col = (int)(it % DFF2); const int rj = (int)(it / DFF2); const bool samp = rj >= 16; const int b = (rj & 15) >> 1, j = rj & 1;
        if (!samp) P.out[O_FCP + ((size_t)b * 2 + j) * DFF2 + col] = bf2f(BND[((size_t)(b * 128 + 127) * 4 + 2 + j) * DFF2 + col]);
        else P.out[O_FCS + ((size_t)b * 2 + j) * DFF2 + col] = bf2f(UPS[(size_t)(b * 16 + 14 + j) * DFF2 + col]); }
}

#define XB_TMO      128
#define XB_XCNT(j)  (256  + 64 * (j))
#define XB_XSUB(j)  (1280 + 64 * (j))
#define XB_XGEN(j)  (2304 + 64 * (j))
#define XB_TOP      3328
#define XB_TOPGEN   3392
#define XCD_BAR_WORDS 3456
#define XB_SPIN_CAP (1u << 18)
#define LAS PG8_LAS

__device__ __forceinline__ unsigned xb_ld(unsigned* p)              { return __hip_atomic_load(p, __ATOMIC_RELAXED, __HIP_MEMORY_SCOPE_AGENT); }
__device__ __forceinline__ unsigned xb_add(unsigned* p, unsigned v) { return __hip_atomic_fetch_add(p, v, __ATOMIC_RELAXED, __HIP_MEMORY_SCOPE_AGENT); }
__device__ __forceinline__ unsigned xb_xcc_id() { return (unsigned)__builtin_amdgcn_s_getreg((3 << 11) | 20) & 0xFu; }
#define XB_SPIN(cond, bar) do { unsigned _sp = 0; while (cond) { __builtin_amdgcn_s_sleep(1); \
    if ((++_sp & 255u) == 0u) { if (xb_ld(&(bar)[XB_TMO])) break; if (_sp > XB_SPIN_CAP) { atomicAdd(&(bar)[XB_TMO], 1u); break; } } } } while (0)

struct XcdBarrier {
    unsigned* bar; unsigned x;
    volatile LAS unsigned* st;
};

__device__ __forceinline__ XcdBarrier xcd_barrier_post(unsigned* bar, volatile LAS unsigned* st) {
    XcdBarrier b; b.bar = bar; b.x = xb_xcc_id(); b.st = st;
    if (threadIdx.x == 0) (void)xb_add(&bar[XB_XCNT(b.x)], 1u);
    return b;
}
__device__ __forceinline__ void xcd_barrier_complete(unsigned* bar, unsigned x, unsigned& nloc, unsigned& nx) {
    const unsigned G = gridDim.x * gridDim.y * gridDim.z;
    unsigned sum, cnt, mine, sp = 0u;
    for (;;) {
        sum = 0u; cnt = 0u; mine = 0u;
#pragma unroll
        for (unsigned j = 0; j < 16; ++j) { const unsigned c = xb_ld(&bar[XB_XCNT(j)]); sum += c; cnt += (c > 0u) ? 1u : 0u; mine = (j == x) ? c : mine; }
        if (sum == G) break;
        __builtin_amdgcn_s_sleep(1);
        if ((++sp & 255u) == 0u) { if (xb_ld(&bar[XB_TMO])) break; if (sp > XB_SPIN_CAP) { atomicAdd(&bar[XB_TMO], 1u); break; } }
    }
    nloc = mine > 0u ? mine : 1u; nx = cnt > 0u ? cnt : 1u;
}

__device__ __forceinline__ void xcd_barrier(const XcdBarrier& b) {
    asm volatile("s_waitcnt vmcnt(0)" ::: "memory");
    __syncthreads();
    if (threadIdx.x == 0) {
        unsigned* bar = b.bar;
        __builtin_amdgcn_s_waitcnt(0);
        unsigned nloc = b.st[0], nx = b.st[1];
        if (nloc == 0u) { xcd_barrier_complete(bar, b.x, nloc, nx); b.st[0] = nloc; b.st[1] = nx; }
        const unsigned old = xb_add(&bar[XB_XSUB(b.x)], 1u);
        const unsigned gen = old / nloc;
        if (old + 1u == (gen + 1u) * nloc) {
            __builtin_amdgcn_fence(__ATOMIC_RELEASE, "agent");
            asm volatile("s_waitcnt vmcnt(0)" ::: "memory");
            const unsigned og = xb_add(&bar[XB_TOP], 1u);
            const unsigned tg = og / nx;
            if (og + 1u == (tg + 1u) * nx) xb_add(&bar[XB_TOPGEN], 1u);
            else XB_SPIN(xb_ld(&bar[XB_TOPGEN]) == tg, bar);
            __builtin_amdgcn_fence(__ATOMIC_ACQUIRE, "agent");
            xb_add(&bar[XB_XGEN(b.x)], 1u);
            asm volatile("s_waitcnt vmcnt(0)" ::: "memory");
        } else {
            XB_SPIN(xb_ld(&bar[XB_XGEN(b.x)]) == gen, bar);
            __builtin_amdgcn_fence(__ATOMIC_ACQUIRE, "agent");
            asm volatile("s_waitcnt vmcnt(0)" ::: "memory");
        }
    }
    __syncthreads();
}

constexpr int NPHASE = 11;
__global__ void __launch_bounds__(512, 2) mega_fwd(Params P) {
    extern __shared__ __attribute__((aligned(16))) unsigned char lds[];
    cg::grid_group grid = cg::this_grid();
    PG8_LAS unsigned char* ldsl = (PG8_LAS unsigned char*)lds;
    unsigned char* ws = P.ws; const int lo = P.ph_lo, hi = P.ph_hi; const int G = gridDim.x, bx = blockIdx.x;
#ifndef PHMASK
#define PHMASK 0xFFFF
#endif
#define IN(k) (((PHMASK >> (k)) & 1) && lo <= (k) && (k) < hi)
    volatile PG8_LAS unsigned* xst = (volatile PG8_LAS unsigned*)(ldsl + LDS_BYTES);
    if (threadIdx.x < 4) xst[threadIdx.x] = 0u;
    __syncthreads();
    XcdBarrier xb = xcd_barrier_post((unsigned*)(ws + WS_BAR), xst);
#define SEAM(k) do { if (IN(k) && IN((k) + 1)) { if ((k) == 0) grid.sync(); else xcd_barrier(xb); } } while (0)
    if (IN(0)) p0_prologue(P, lds);
    SEAM(0);
    if (IN(1)) { pg8::Gemm g{(const bf16_t*)(ws + WS_XB), (const bf16_t*)(ws + WS_WIN), TOKP, NIN, 1024}; pg8::StaticOrder S; S.init(TOKP, NIN, G, bx);
        pg8::EpiPlain E{(bf16_t*)(ws + WS_PROJ), NIN, 4, 1.f}; pg8::gemm_phase<pg8::EpiPlain, pg8::StaticOrder, true, true>(ldsl, g, S, E); }
    SEAM(1);
    if (IN(2)) p2_token(P);
    SEAM(2);
    if (IN(3)) {
#ifndef NOQ
        { pg8::Gemm g{(const bf16_t*)(ws + WS_CQN), (const bf16_t*)(ws + WS_WUQ), TOKP, 768, 384}; pg8::StaticOrder S; S.init(TOKP, 768, G, bx);
          pg8::EpiPlain E{(bf16_t*)(ws + WS_QB), 768, 0, QSCALE}; pg8::gemm_phase<pg8::EpiPlain, pg8::StaticOrder, true, true>(ldsl, g, S, E); }
#endif
#ifndef NOKV
        { pg8::Gemm g{(const bf16_t*)(ws + WS_CKVN), (const bf16_t*)(ws + WS_WKV), KVRP, 1024, 256}; pg8::StaticOrder S; S.init(KVRP, 1024, G, bx);
          pg8::EpiPlain E{(bf16_t*)(ws + WS_KVB), 1024, 0, 1.f}; pg8::gemm_phase<pg8::EpiPlain, pg8::StaticOrder, true, true>(ldsl, g, S, E); }
#endif
#ifndef NOSP
        spatial_phase(P, lds);
#endif
    }
    SEAM(3);
    if (IN(4)) att::attn_phase(P, lds);
    SEAM(4);
    if (IN(5)) { pg8::Gemm g{(const bf16_t*)(ws + WS_CAT), (const bf16_t*)(ws + WS_WO), TOKP, 1024, 1024}; pg8::StaticOrder S; S.init(TOKP, 1024, G, bx);
        pg8::EpiWo E{(bf16_t*)(ws + WS_R1), P.in[0], P.in[1]}; pg8::gemm_phase<pg8::EpiWo, pg8::StaticOrder, true, true>(ldsl, g, S, E); }
    SEAM(5);
    if (IN(6)) ln1_phase(P);
    SEAM(6);
    if (IN(7)) { pg8::Gemm g{(const bf16_t*)(ws + WS_H), (const bf16_t*)(ws + WS_WUP), TOKP, DFF2, 1024}; pg8::UpOrder S; S.init(TOKP, DFF2, G, bx);
        S.slots = (PG8_LAS float*)(ldsl + LDS_BYTES + 256); S.wcv = P.in[19]; S.bcv = P.in[20]; S.cnt = 0;
        pg8::EpiUpConv E{(bf16_t*)(ws + WS_ACT), (bf16_t*)(ws + WS_BND), (bf16_t*)(ws + WS_UPS), (PG8_LAS const float*)(ldsl + LDS_BYTES + 256), 0}; pg8::gemm_phase<pg8::EpiUpConv, pg8::UpOrder, true, true>(ldsl, g, S, E); }
    SEAM(7);
    if (IN(8)) ffn_fix_phase(P);
    SEAM(8);
    if (IN(9)) { pg8::Gemm g{(const bf16_t*)(ws + WS_ACT), (const bf16_t*)(ws + WS_WDN), TOKP, 1024, DFF}; pg8::StaticOrder S; S.init(TOKP, 1024, G, bx);
        pg8::EpiDown E{P.out + O_YP, (const bf16_t*)(ws + WS_H)}; pg8::gemm_phase<pg8::EpiDown, pg8::StaticOrder, true, true>(ldsl, g, S, E); }
    SEAM(9);
    if (IN(10)) ln2_phase(P);
#undef IN
#undef SEAM
}

extern "C" void kernel_launch(void* const* d_in, const int* in_sizes, int n_in, void* d_out, int out_size, void* d_ws, size_t ws_size, hipStream_t stream) {
    static int grid_blocks = 0;
    if (grid_blocks == 0) {
        if (n_in != 24 || out_size != (int)O_END || ws_size < WS_TOTAL) { fprintf(stderr, "kernel_launch: unexpected shapes: n_in %d out %d ws %zu (need %zu)\n", n_in, out_size, ws_size, (size_t)WS_TOTAL); grid_blocks = -1; return; }
        int dev = 0, cus = 0, per_cu = 0;
        hipGetDevice(&dev); hipDeviceGetAttribute(&cus, hipDeviceAttributeMultiprocessorCount, dev);
        if (hipFuncSetAttribute((const void*)mega_fwd, hipFuncAttributeMaxDynamicSharedMemorySize, LDS_BYTES + 256 + 8192) != hipSuccess) { fprintf(stderr, "kernel_launch: hipFuncSetAttribute failed\n"); grid_blocks = -1; return; }
        if (hipOccupancyMaxActiveBlocksPerMultiprocessor(&per_cu, (const void*)mega_fwd, 512, LDS_BYTES + 256 + 8192) != hipSuccess || per_cu < 1) { fprintf(stderr, "kernel_launch: occupancy query gave %d\n", per_cu); per_cu = 1; }
        (void)hipGetLastError();
        grid_blocks = cus * 1;
    }
    if (grid_blocks < 0) return;
    if (hipMemsetAsync((char*)d_ws + WS_BAR, 0, 16384, stream) != hipSuccess) { fprintf(stderr, "kernel_launch: memset failed\n"); return; }
    Params p{};
    for (int i = 0; i < 24; ++i) p.in[i] = (const float*)d_in[i];
    p.out = (float*)d_out; p.ws = (unsigned char*)d_ws;
#if defined(MK_MULTI)
    for (int ph = 0; ph < NPHASE; ++ph) { p.ph_lo = ph; p.ph_hi = ph + 1; hipLaunchKernelGGL(mega_fwd, dim3(grid_blocks), dim3(512), LDS_BYTES + 256 + 8192, stream, p); }
#else
    p.ph_lo = 0; p.ph_hi = NPHASE;
    void* args[] = {&p};
    hipError_t e = hipLaunchCooperativeKernel((const void*)mega_fwd, dim3(grid_blocks), dim3(512), args, LDS_BYTES + 256 + 8192, stream);
    if (e != hipSuccess) fprintf(stderr, "kernel_launch: cooperative launch failed: %s (grid %d)\n", hipGetErrorString(e), grid_blocks);
#endif
}
```
